# Optimizing an MI355X kernel written in HIP

```python
import jax, jax.numpy as jnp
from jax import lax
import numpy as np

D_MODEL = 1024
BATCH = 2
SEQ = 8192
DEPTH = 1

CTX_LEN = 256
GRID_W = 64
D_FOURIER = D_MODEL // 2
FOURIER_GROUPS = 4
FOURIER_GROUP_DIM = D_FOURIER // FOURIER_GROUPS
D_REC = D_MODEL - D_FOURIER
REC_HEADS = 4
REC_HEAD_DIM = D_REC // REC_HEADS
CHUNK = 64
SUB_CHUNK = 16
N_EXPERTS = 16
EC_CAPACITY_FACTOR = 2
D_EXPERT = 2816
NORM_EPS = 1e-6
D_IN = D_FOURIER + 5 * D_REC
N_ADA = 6

kernel_name = "hybrid_fnet_hgrn2_ec_moe_dit"


def rms_norm(x, gain):
    xf = x.astype(jnp.float32)
    y = xf * lax.rsqrt(jnp.mean(xf * xf, axis=-1, keepdims=True) + NORM_EPS)
    return (y * gain.astype(jnp.float32)).astype(x.dtype)


def adaln(cond, w, b):
    mod = (jax.nn.silu(cond) @ w + b)[:, None, :]
    return jnp.split(mod, N_ADA, axis=-1)


def modulate(h, shift, scale):
    return h * (1 + scale) + shift


def fourier_mix(u, w_f):
    b_, l_, _ = u.shape
    z = u.astype(jnp.float32).reshape(b_, l_, FOURIER_GROUPS, FOURIER_GROUP_DIM)
    z = jnp.fft.fft2(z, axes=(1, 3), norm="ortho").real.astype(u.dtype)
    y = jnp.einsum('blgc,gcd->blgd', z, w_f)
    return y.reshape(b_, l_, D_FOURIER)


def _to_chunks(t):
    b_, l_, h_, d_ = t.shape
    return t.reshape(b_, l_ // CHUNK, CHUNK, h_, d_).transpose(1, 0, 3, 2, 4)


def _from_chunks(t):
    n_, b_, h_, c_, d_ = t.shape
    return t.transpose(1, 0, 3, 2, 4).reshape(b_, n_ * c_, h_, d_)


def _chunk_step(S, inp):
    qc, kc, vc, lc = inp
    b_, h_, c_, d_ = qc.shape
    ns = c_ // SUB_CHUNK
    bcum = jnp.cumsum(lc, axis=2)
    o_inter = jnp.einsum('bhcd,bhde->bhce', qc * jnp.exp(bcum), S)
    bs = bcum.reshape(b_, h_, ns, SUB_CHUNK, d_)
    qs = qc.reshape(b_, h_, ns, SUB_CHUNK, d_)
    ks = kc.reshape(b_, h_, ns, SUB_CHUNK, d_)
    vs = vc.reshape(b_, h_, ns, SUB_CHUNK, -1)
    b_ref = jnp.concatenate([jnp.zeros_like(bs[:, :, :1, 0]), bs[:, :, :-1, -1]], axis=2)
    q_hat = qs * jnp.exp(bs - b_ref[:, :, :, None, :])
    prev = jnp.arange(c_)[None, :] < (jnp.arange(ns) * SUB_CHUNK)[:, None]
    k_hat = kc[:, :, None] * jnp.exp(jnp.where(prev[:, :, None],
                                               b_ref[:, :, :, None, :] - bcum[:, :, None], -jnp.inf))
    a_off = jnp.einsum('bhjtd,bhjsd->bhjts', q_hat, k_hat)
    tri = jnp.tril(jnp.ones((SUB_CHUNK, SUB_CHUNK), dtype=bool))
    decay = jnp.exp(jnp.where(tri[:, :, None],
                              bs[:, :, :, :, None, :] - bs[:, :, :, None, :, :], -jnp.inf))
    a_diag = jnp.einsum('bhjtd,bhjtsd,bhjsd->bhjts', qs, decay, ks)
    o_intra = (jnp.einsum('bhjts,bhse->bhjte', a_off, vc)
               + jnp.einsum('bhjts,bhjse->bhjte', a_diag, vs))
    o = o_inter + o_intra.reshape(b_, h_, c_, -1)
    b_last = bcum[:, :, -1]
    S_new = (jnp.exp(b_last)[..., None] * S
             + jnp.einsum('bhcd,bhce->bhde', kc * jnp.exp(b_last[:, :, None] - bcum), vc))
    return S_new, o


def scan_dir(q, k, v, logf, S0, reverse):
    if reverse:
        q, k, v, logf = (jnp.flip(t, axis=1) for t in (q, k, v, logf))
    S_fin, o = lax.scan(_chunk_step, S0, (_to_chunks(q), _to_chunks(k), _to_chunks(v), _to_chunks(logf)))
    o = _from_chunks(o)
    if reverse:
        o = jnp.flip(o, axis=1)
    return o, S_fin


def split_proj(p, lb):
    b_, l_, _ = p.shape
    u, q, v, f_f, f_b, g = jnp.split(p, [D_FOURIER + i * D_REC for i in range(5)], axis=-1)
    heads = lambda t: t.astype(jnp.float32).reshape(b_, l_, REC_HEADS, REC_HEAD_DIM)

    def gates(fp, lbd):
        lbd = lbd.reshape(REC_HEADS, REC_HEAD_DIM)
        fg = lbd + (1 - lbd) * jax.nn.sigmoid(heads(fp))
        return jnp.log(fg), 1 - fg

    return u, jax.nn.silu(heads(q)), heads(v), gates(f_f, lb[0]), gates(f_b, lb[1]), g


def rec_mixer(q, v, gf, gb, g, S0_f, S0_b, gain):
    o_f, S_f = scan_dir(q, gf[1], v, gf[0], S0_f, False)
    o_b, S_b = scan_dir(q, gb[1], v, gb[0], S0_b, True)
    o = o_f + o_b
    o = o * lax.rsqrt(jnp.mean(o * o, axis=-1, keepdims=True) + NORM_EPS)
    o = o * gain.astype(jnp.float32).reshape(REC_HEADS, REC_HEAD_DIM)
    b_, l_ = o.shape[:2]
    y = o.reshape(b_, l_, D_REC).astype(g.dtype) * jax.nn.silu(g)
    return y, S_f, S_b


def ec_moe(h, w_r, w_g, w_u, w_d):
    b_, l_, d_ = h.shape
    cap = EC_CAPACITY_FACTOR * l_ // N_EXPERTS
    affinity = jax.nn.softmax((h @ w_r).astype(jnp.float32), axis=-1)
    gate, idx = lax.top_k(jnp.swapaxes(affinity, 1, 2), cap)
    xs = jax.vmap(lambda hb, ib: hb[ib])(h, idx)
    hid = jax.nn.silu(jnp.einsum('becd,edf->becf', xs, w_g)) * jnp.einsum('becd,edf->becf', xs, w_u)
    ye = jnp.einsum('becf,efd->becd', hid, w_d) * gate[..., None].astype(h.dtype)
    flat = (idx + jnp.arange(b_)[:, None, None] * l_).reshape(-1)
    out = jax.ops.segment_sum(ye.reshape(-1, d_), flat, num_segments=b_ * l_)
    return out.reshape(b_, l_, d_)


def setup_inputs(seed: int = 0) -> dict:
    key = jax.random.key(seed)
    ks = jax.random.split(key, 20)
    nrm = lambda k, shape, s: jax.random.normal(k, shape, jnp.float32) * s
    D = D_MODEL
    return {
        "x": nrm(ks[0], (BATCH, SEQ, D), 1.0),
        "c": nrm(ks[1], (BATCH, D), 1.0),
        "ctx": nrm(ks[2], (BATCH, CTX_LEN, D), 1.0),
        "c_ctx": nrm(ks[3], (D,), 1.0),
        "w_ada": nrm(ks[4], (DEPTH, D, N_ADA * D), 0.5 * D ** -0.5),
        "b_ada": nrm(ks[5], (DEPTH, N_ADA * D), 0.01),
        "g_mix": 1.0 + nrm(ks[6], (DEPTH, D), 0.02),
        "w_in": nrm(ks[7], (DEPTH, D, D_IN), D ** -0.5),
        "w_fourier": nrm(ks[8], (DEPTH, FOURIER_GROUPS, FOURIER_GROUP_DIM, FOURIER_GROUP_DIM), FOURIER_GROUP_DIM ** -0.5),
        "lb_logits": nrm(ks[9], (DEPTH + 1, 2, D_REC), 0.5),
        "g_rec": 1.0 + nrm(ks[10], (DEPTH, D_REC), 0.02),
        "w_out": nrm(ks[11], (DEPTH, D, D), D ** -0.5),
        "g_ffn": 1.0 + nrm(ks[12], (DEPTH, D), 0.02),
        "w_router": nrm(ks[13], (DEPTH, D, N_EXPERTS), D ** -0.5),
        "w_exp_gate": nrm(ks[14], (DEPTH, N_EXPERTS, D, D_EXPERT), D ** -0.5),
        "w_exp_up": nrm(ks[15], (DEPTH, N_EXPERTS, D, D_EXPERT), D ** -0.5),
        "w_exp_down": nrm(ks[16], (DEPTH, N_EXPERTS, D_EXPERT, D), D_EXPERT ** -0.5),
        "g_final": 1.0 + nrm(ks[17], (D,), 0.02),
    }


def reference(x, c, ctx, c_ctx, w_ada, b_ada, g_mix, w_in, w_fourier, lb_logits, g_rec, w_out,
              g_ffn, w_router, w_exp_gate, w_exp_up, w_exp_down, g_final):
    b_ = x.shape[0]
    lb_all = jnp.cumsum(jax.nn.softmax(lb_logits.astype(jnp.float32), axis=0), axis=0)
    for layer in range(DEPTH):
        ctx_out_needed = layer < DEPTH - 1
        sh1, sc1, gt1, sh2, sc2, gt2 = adaln(c, w_ada[layer], b_ada[layer])
        sh1c, sc1c, gt1c, sh2c, sc2c, gt2c = adaln(c_ctx[None], w_ada[layer], b_ada[layer])
        lb = lb_all[layer]

        h_ctx = modulate(rms_norm(ctx, g_mix[layer]), sh1c, sc1c)
        h_lat = modulate(rms_norm(x, g_mix[layer]), sh1, sc1)
        u_c, q_c, v_c, gf_c, gb_c, g_c = split_proj(h_ctx @ w_in[layer], lb)
        u_l, q_l, v_l, gf_l, gb_l, g_l = split_proj(h_lat @ w_in[layer], lb)

        S_zero = jnp.zeros((b_, REC_HEADS, REC_HEAD_DIM, REC_HEAD_DIM), jnp.float32)
        rec_c, S_cf, S_cb = rec_mixer(q_c, v_c, gf_c, gb_c, g_c, S_zero, S_zero, g_rec[layer])
        rec_l, _, _ = rec_mixer(q_l, v_l, gf_l, gb_l, g_l, S_cf, S_cb, g_rec[layer])

        mix_l = jnp.concatenate([fourier_mix(u_l, w_fourier[layer]), rec_l], axis=-1) @ w_out[layer]
        x = x + gt1 * mix_l
        if ctx_out_needed:
            mix_c = jnp.concatenate([fourier_mix(u_c, w_fourier[layer]), rec_c], axis=-1) @ w_out[layer]
            ctx = ctx + gt1c * mix_c

        x = x + gt2 * ec_moe(modulate(rms_norm(x, g_ffn[layer]), sh2, sc2), w_router[layer],
                             w_exp_gate[layer], w_exp_up[layer], w_exp_down[layer])
        if ctx_out_needed:
            ctx = ctx + gt2c * ec_moe(modulate(rms_norm(ctx, g_ffn[layer]), sh2c, sc2c), w_router[layer],
                                      w_exp_gate[layer], w_exp_up[layer], w_exp_down[layer])
    return rms_norm(x, g_final)
```

```cpp
#include <hip/hip_runtime.h>
#include <hip/hip_cooperative_groups.h>
#include <cstdio>
namespace cg = cooperative_groups;

constexpr int NB_ = 2, L_ = 8192, D_ = 1024, CTX_ = 256, DIN_ = 3072, NE_ = 16, CAP_ = 1024, DE_ = 2816;
constexpr int RL_ = NB_ * L_, RC_ = NB_ * CTX_, RT_ = RL_ + RC_;
constexpr float EPS_ = 1e-6f;

constexpr size_t WS_MOD = 0;
constexpr size_t WS_LB = WS_MOD + 3 * 6144 * 4;
constexpr size_t WS_COS = WS_LB + 2 * 512 * 4;
constexpr size_t WS_AFF = WS_COS + 8192 * 4;
constexpr size_t WS_IDX = WS_AFF + (size_t)RL_ * 16 * 4;
constexpr size_t WS_GATE = WS_IDX + 2 * 16 * 1024 * 4;
constexpr size_t WS_SLOT = WS_GATE + 2 * 16 * 1024 * 4;
constexpr size_t WS_GATER = WS_SLOT + (size_t)RL_ * 16 * 4;
constexpr size_t WS_WINT = (WS_GATER + 32768 * 4 + 4095) / 4096 * 4096;
constexpr size_t WS_WOUTT = WS_WINT + (size_t)DIN_ * D_ * 2;
constexpr size_t WS_PU = WS_WOUTT + (size_t)D_ * D_ * 2;
constexpr size_t WS_W12T = WS_PU + (size_t)RL_ * 512 * 2;
constexpr size_t WS_FA = WS_W12T + 4 * 256 * 128 * 2;
constexpr size_t WS_FC = WS_FA + 256 * 256 * 2;
constexpr size_t WS_MODP = WS_FC + 64 * 128 * 2;
constexpr size_t WS_BAR = WS_MODP + 8 * 3 * 6144 * 4;
constexpr size_t WS_WGU = (WS_BAR + 16384 + 4095) / 4096 * 4096;
constexpr size_t WS_WD = WS_WGU + (size_t)16 * 22 * 256 * 1024;
constexpr size_t WS_YE = WS_WGU;
constexpr size_t WS_RC = WS_WD + (size_t)16 * 1024 * 2816;
constexpr size_t RC_HCAT = WS_RC;
constexpr size_t RC_PQ = RC_HCAT + (size_t)RT_ * D_ * 2;
constexpr size_t RC_PV = RC_PQ + (size_t)RT_ * 512 * 2;
constexpr size_t RC_PG = RC_PV + (size_t)RT_ * 512 * 2;
constexpr size_t RC_PF = RC_PG + (size_t)RT_ * 512 * 2;
constexpr size_t RC_XF = RC_PF + (size_t)RT_ * 1024 * 2;
constexpr size_t RC_YF = RC_XF + (size_t)RL_ * 512 * 2 * 2;
constexpr size_t RC_USEG = RC_YF + (size_t)RL_ * 512 * 2 * 2;
constexpr size_t RC_SST = RC_USEG + (size_t)320 * 16384 * 4;
constexpr size_t RC_GSEG = RC_SST + (size_t)256 * 16384 * 4;
constexpr size_t RC_OF = RC_GSEG + 320 * 128 * 4;
constexpr size_t RC_OB = RC_OF + (size_t)RL_ * 512 * 2;
constexpr size_t RC_MIX = RC_OB + (size_t)RL_ * 512 * 2;
constexpr size_t RC_END1 = RC_MIX + (size_t)RL_ * D_ * 2;
constexpr size_t RC_X1 = WS_RC;
constexpr size_t RC_H2B = RC_PG;
constexpr size_t RC_XS = RC_H2B + (size_t)RL_ * D_;
constexpr size_t RC_HID = RC_XS + (size_t)32768 * D_;
constexpr size_t RC_END2 = RC_HID + (size_t)32768 * DE_;
constexpr size_t WS_END = RC_END1 > RC_END2 ? RC_END1 : RC_END2;
static_assert(RC_X1 + (size_t)RL_ * D_ * 2 <= RC_PG, "X1 overlay");
static_assert(WS_END <= (size_t)4 * 16 * 1024 * 2816 * 4, "workspace budget (4 x largest input)");

struct Params {
    const float *x, *c, *ctx, *c_ctx, *w_ada, *b_ada, *g_mix, *w_in, *w_f, *lb_logits, *g_rec, *w_out, *g_ffn, *w_router, *w_g, *w_u, *w_d, *g_final;
    float* out;
    unsigned char* ws;
};

typedef const __attribute__((address_space(4))) Params* KP;
__device__ __forceinline__ KP kargs() { KP k = (KP)__builtin_amdgcn_kernarg_segment_ptr(); asm volatile("" : "+s"(k)); return k; }
__device__ __forceinline__ int ltid() { int t = threadIdx.x; asm volatile("" : "+v"(t)); return t; }
__device__ __forceinline__ float siluf(float v) { return v * __builtin_amdgcn_rcpf(1.0f + __expf(-v)); }
__device__ __forceinline__ float sigmf(float v) { return __builtin_amdgcn_rcpf(1.0f + __expf(-v)); }
__device__ __forceinline__ float wave_sum(float v) {
#pragma unroll
    for (int o = 32; o >= 1; o >>= 1) v += __shfl_xor(v, o);
    return v;
}

namespace pg8 {
#define PG8_LAS __attribute__((address_space(3)))
typedef unsigned short bf16_t;
typedef short bf16x8 __attribute__((ext_vector_type(8)));
typedef float f32x4 __attribute__((ext_vector_type(4)));
typedef unsigned u32x4 __attribute__((ext_vector_type(4)));
constexpr int BM = 256, BK = 64, HALF = 128, HTB = HALF * BK * 2, STAGE_BYTES = 8 * HTB;
__device__ __forceinline__ int lds_byte(int r, int c) { const int st = (r >> 4) * 2 + (c >> 5), rr = r & 15, cc = c & 31, ob = rr * 64 + cc * 2; return st * 1024 + (ob ^ (((ob >> 9) & 1) << 5)); }
__device__ __forceinline__ void stage_rc(int b, int& R, int& C) { const int st = b / 1024, sb = b % 1024, swz = sb ^ (((sb >> 9) & 1) << 5); R = (st >> 1) * 16 + swz / 64; C = (st & 1) * 32 + (swz % 64) / 2; }
__device__ __forceinline__ int perm32(int rho) { const int n = rho >> 4, i = rho & 15; return 8 * (i >> 2) + 4 * n + (i & 3); }
struct Unit { int pm, pn; };
struct Gemm { const bf16_t* A; const bf16_t* Bt; int K; };
typedef float f32x2_t __attribute__((ext_vector_type(2)));
typedef __bf16 bf16x2_t __attribute__((ext_vector_type(2)));
__device__ __forceinline__ unsigned cvt_pk_bf16(float lo, float hi) { const f32x2_t v = {lo, hi}; const bf16x2_t r = __builtin_convertvector(v, bf16x2_t); return __builtin_bit_cast(unsigned, r); }

template <class Epi, class Sched, bool GATHER = false, int FP8SC = 0>
__device__ __forceinline__ void gemm_phase(PG8_LAS unsigned char* lds, const Gemm g, const Sched& S, const Epi& E, const PG8_LAS unsigned* gofs = nullptr) {
    const int tidx_ = ltid();
    const int tid = tidx_, wid = __builtin_amdgcn_readfirstlane(tid >> 6), lane = tid & 63, wr = wid >> 2, wc = wid & 3, fr = lane & 15, fq = lane >> 4;
    const int K = g.K, nt = K / BK;
    unsigned vA[2][2], nvA[2][2], voffB[2]; int RA[2], CA[2];
    const unsigned hstepu = (unsigned)HALF * (unsigned)K * 2u;
#pragma unroll
    for (int i = 0; i < 2; ++i) { int R, C; stage_rc(tid * 16 + i * 8192, R, C); const int Rb = Epi::PERM ? ((R & ~31) + perm32(R & 31)) : R; RA[i] = R; CA[i] = C;
        voffB[i] = (unsigned)(Rb * K + C) * 2u;
        if (GATHER) { vA[0][i] = gofs[R] + (unsigned)C * 2u; vA[1][i] = gofs[HALF + R] + (unsigned)C * 2u; }
        else { vA[0][i] = (unsigned)(R * K + C) * 2u; vA[1][i] = vA[0][i] + hstepu; }
        nvA[0][i] = vA[0][i]; nvA[1][i] = vA[1][i]; }
    const size_t kstep = (size_t)(BK * 2);
    const size_t hstep = (size_t)HALF * K * 2;
    const size_t tstep = 2 * hstep;
    const unsigned ldsw = (unsigned)wid * 1024u;
    const int aoff = lds_byte(wr * 64 + fr, fq * 8), boff = lds_byte(wc * 32 + fr, fq * 8);
#define PG8_SA(b, h) (((b) * 2 + (h)) * HTB)
#define PG8_SB(b, h) ((4 + (b) * 2 + (h)) * HTB)
#define PG8_STAGE(bufoff, gbase, voff) do { _Pragma("unroll") for (int _i = 0; _i < 2; ++_i) \
        __builtin_amdgcn_global_load_lds((const unsigned*)((const char*)(gbase) + (voff)[_i]), (PG8_LAS unsigned*)(lds + (bufoff) + ldsw + _i * 8192), 16, 0, 0); } while (0)
    typedef int v4i_ __attribute__((ext_vector_type(4))); typedef int v8i_ __attribute__((ext_vector_type(8)));
#define PG8_LDA(dst, dst8, b, h) do { _Pragma("unroll") for (int m = 0; m < 4; ++m) { if constexpr (FP8SC != 0) dst8[m] = __builtin_shufflevector(*(const PG8_LAS v4i_*)(lds + PG8_SA(b, h) + aoff + m * 2048), *(const PG8_LAS v4i_*)(lds + PG8_SA(b, h) + aoff + m * 2048 + 1024), 0, 1, 2, 3, 4, 5, 6, 7); \
        else { _Pragma("unroll") for (int k = 0; k < 2; ++k) dst[m][k] = *(const PG8_LAS bf16x8*)(lds + PG8_SA(b, h) + aoff + m * 2048 + k * 1024); } } } while (0)
#define PG8_LDB(dst, dst8, b, h) do { _Pragma("unroll") for (int n = 0; n < 2; ++n) { if constexpr (FP8SC != 0) dst8[n] = __builtin_shufflevector(*(const PG8_LAS v4i_*)(lds + PG8_SB(b, h) + boff + n * 2048), *(const PG8_LAS v4i_*)(lds + PG8_SB(b, h) + boff + n * 2048 + 1024), 0, 1, 2, 3, 4, 5, 6, 7); \
        else { _Pragma("unroll") for (int k = 0; k < 2; ++k) dst[n][k] = *(const PG8_LAS bf16x8*)(lds + PG8_SB(b, h) + boff + n * 2048 + k * 1024); } } } while (0)
#define PG8_MMA(ai, bj, At, At8, Bt, Bt8) do { __builtin_amdgcn_s_setprio(1); _Pragma("unroll") for (int m = 0; m < 4; ++m) _Pragma("unroll") for (int n = 0; n < 2; ++n) { \
        if constexpr (FP8SC != 0) asm volatile("v_mfma_scale_f32_16x16x128_f8f6f4 %0, %1, %2, %0, %3, %4 op_sel_hi:[0,0,0]" : "+v"(acc[ai][bj][m][n]) : "v"(Bt8[n]), "v"(At8[m]), "v"(scw), "v"(sca));   \
        else { _Pragma("unroll") for (int k = 0; k < 2; ++k) acc[ai][bj][m][n] = __builtin_amdgcn_mfma_f32_16x16x32_bf16(Bt[n][k], At[m][k], acc[ai][bj][m][n], 0, 0, 0); } } \
        __builtin_amdgcn_s_setprio(0); } while (0)
#define PG8_WAIT_V(n) asm volatile("s_waitcnt vmcnt(" #n ")" ::: "memory")
#define PG8_WAIT_L(n) asm volatile("s_waitcnt lgkmcnt(" #n ")" ::: "memory")
#define PG8_BAR __builtin_amdgcn_s_barrier()
#define PG8_SCHED __builtin_amdgcn_sched_barrier(0)
    Unit cur, nxt; int ui = 0;
    if (!S.next(0, cur)) return;
    f32x4 acc[2][2][4][2];
#pragma unroll
    for (int a = 0; a < 2; ++a)
#pragma unroll
        for (int b = 0; b < 2; ++b)
#pragma unroll
            for (int m = 0; m < 4; ++m)
#pragma unroll
                for (int n = 0; n < 2; ++n) acc[a][b][m][n] = (f32x4){0.f, 0.f, 0.f, 0.f};
    bf16x8 At[4][2], B0[2][2], B1[2][2]; v8i_ At8[4], B08[2], B18[2];
    int scw = (FP8SC & 0xff) * 0x01010101, sca = ((FP8SC >> 8) & 0xff) * 0x01010101;
    if constexpr (FP8SC != 0) asm volatile("" : "+v"(scw), "+v"(sca));
    const char* cA = (const char*)g.A + (GATHER ? (size_t)0 : (size_t)cur.pm * tstep); const char* cB = (const char*)g.Bt + (size_t)cur.pn * tstep;
    PG8_STAGE(PG8_SB(0, 0), cB, voffB); PG8_STAGE(PG8_SB(0, 1), cB + hstep, voffB); PG8_STAGE(PG8_SA(0, 0), cA, vA[0]); PG8_STAGE(PG8_SA(0, 1), cA, vA[1]);
    if (wr == 1) PG8_BAR;
    PG8_WAIT_V(2); PG8_BAR;
    PG8_STAGE(PG8_SB(1, 0), cB + kstep, voffB); PG8_STAGE(PG8_SA(1, 0), cA + kstep, vA[0]); PG8_STAGE(PG8_SB(1, 1), cB + hstep + kstep, voffB);
    PG8_WAIT_V(6); PG8_BAR;
    for (;;) {
        const bool has_next = S.next(ui + 1, nxt);
        const char* nA = (has_next && !GATHER) ? (const char*)g.A + (size_t)nxt.pm * tstep : cA; const char* nB = has_next ? (const char*)g.Bt + (size_t)nxt.pn * tstep : cB;
        for (int t = 0; t < nt; t += 2) {
            const bool last = (t == nt - 2);
            const char* a1 = cA + (size_t)(t + 1) * kstep;
            const char* a2 = last ? nA : cA + (size_t)(t + 2) * kstep; const char* b2 = last ? nB : cB + (size_t)(t + 2) * kstep;
            const char* a3 = a2 + kstep; const char* b3 = b2 + kstep;
            if (GATHER && last && has_next) {
#pragma unroll
                for (int i = 0; i < 2; ++i) { nvA[0][i] = gofs[(ui + 1) * 256 + RA[i]] + (unsigned)CA[i] * 2u; nvA[1][i] = gofs[(ui + 1) * 256 + HALF + RA[i]] + (unsigned)CA[i] * 2u; }
            }
            unsigned uA[2][2];
#pragma unroll
            for (int i = 0; i < 2; ++i) { uA[0][i] = last ? nvA[0][i] : vA[0][i]; uA[1][i] = last ? nvA[1][i] : vA[1][i]; }
            PG8_LDB(B0, B08, 0, 0); PG8_LDB(B1, B18, 0, 1); PG8_SCHED; PG8_LDA(At, At8, 0, 0); PG8_STAGE(PG8_SA(1, 1), a1, vA[1]);
            PG8_WAIT_V(8); PG8_WAIT_L(0); PG8_BAR; PG8_MMA(0, 0, At, At8, B0, B08); PG8_MMA(0, 1, At, At8, B1, B18); PG8_BAR; PG8_SCHED;
            PG8_LDA(At, At8, 0, 1); PG8_STAGE(PG8_SB(0, 0), b2, voffB); PG8_STAGE(PG8_SB(0, 1), b2 + hstep, voffB); PG8_STAGE(PG8_SA(0, 0), a2, uA[0]);
            PG8_WAIT_V(8); PG8_WAIT_L(0); PG8_BAR; PG8_MMA(1, 0, At, At8, B0, B08); PG8_MMA(1, 1, At, At8, B1, B18); PG8_BAR; PG8_SCHED;
            PG8_LDB(B0, B08, 1, 0); PG8_LDB(B1, B18, 1, 1); PG8_SCHED; PG8_LDA(At, At8, 1, 0); PG8_STAGE(PG8_SA(0, 1), a2, uA[1]);
            PG8_WAIT_V(8); PG8_WAIT_L(0); PG8_BAR; PG8_MMA(0, 0, At, At8, B0, B08); PG8_MMA(0, 1, At, At8, B1, B18); PG8_BAR; PG8_SCHED;
            PG8_LDA(At, At8, 1, 1); PG8_STAGE(PG8_SB(1, 0), b3, voffB); PG8_STAGE(PG8_SB(1, 1), b3 + hstep, voffB); PG8_STAGE(PG8_SA(1, 0), a3, uA[0]);
            PG8_WAIT_V(8); PG8_WAIT_L(0); PG8_BAR; PG8_MMA(1, 0, At, At8, B0, B08); PG8_MMA(1, 1, At, At8, B1, B18); PG8_BAR; PG8_SCHED;
        }
        if (wr == 0) PG8_BAR;
        if constexpr (FP8SC != 0) asm volatile("s_nop 15\n\ts_nop 15" ::: "memory");
        E(acc, cur, wr, wc, fr, fq);
        if (!has_next) break;
#pragma unroll
        for (int a = 0; a < 2; ++a)
#pragma unroll
            for (int b = 0; b < 2; ++b)
#pragma unroll
                for (int m = 0; m < 4; ++m)
#pragma unroll
                    for (int n = 0; n < 2; ++n) acc[a][b][m][n] = (f32x4){0.f, 0.f, 0.f, 0.f};
        cur = nxt; cA = nA; cB = nB; ++ui;
#pragma unroll
        for (int i = 0; i < 2; ++i) { vA[0][i] = nvA[0][i]; vA[1][i] = nvA[1][i]; }
        if (wr == 1) PG8_BAR;
    }
    PG8_WAIT_V(0);
    PG8_BAR;
#undef PG8_SA
#undef PG8_SB
#undef PG8_STAGE
#undef PG8_LDA
#undef PG8_LDB
#undef PG8_MMA
#undef PG8_WAIT_V
#undef PG8_WAIT_L
#undef PG8_BAR
#undef PG8_SCHED
}
}


typedef unsigned u32x2_t __attribute__((ext_vector_type(2)));
typedef _Float16 h4v_t __attribute__((ext_vector_type(4)));
typedef _Float16 h8v_t __attribute__((ext_vector_type(8)));
struct SchedDense {
    int nM, nN, nwg, G, c, m0;
    __device__ void init(int M, int N, int G_, int c_, int m0_ = 0) { nM = M / 256; nN = N / 256; nwg = nM * nN; G = G_; c = c_; m0 = m0_; }
    __device__ bool next(int i, pg8::Unit& u) const {
        const int L = i * G + c; if (L >= nwg) return false;
        int wgid = L; { const int q = nwg / 8, r = nwg % 8, xcd = wgid % 8, off = wgid / 8; wgid = (xcd < r ? xcd * (q + 1) : r * (q + 1) + (xcd - r) * q) + off; }
        const int nig = 8 * nN, gid = wgid / nig, fm = gid * 8, gsz = (nM - fm) < 8 ? (nM - fm) : 8;
        u.pm = m0 + fm + ((wgid % nig) % gsz); u.pn = (wgid % nig) / gsz; return true;
    }
};
struct EpiWin {
    static constexpr bool PERM = false;
    unsigned char* ws; const float* lb;
    __device__ __forceinline__ void operator()(const pg8::f32x4 (&acc)[2][2][4][2], const pg8::Unit& u, int wr, int wc, int fr, int fq) const {
        const int row0 = u.pm * 256 + wr * 64 + fr, ct = u.pn, colw = (ct & 1) * 256 + wc * 32 + 4 * fq;
        if (ct >= 6 && ct <= 9) {
            unsigned short* PF = (unsigned short*)(ws + RC_PF); const int cg = (ct - 6) * 256 + wc * 32 + 4 * fq;
#pragma unroll
            for (int bj = 0; bj < 2; ++bj)
#pragma unroll
                for (int n = 0; n < 2; ++n) {
                    const int col = cg + bj * 128 + n * 16; const pg8::f32x4 l = *(const pg8::f32x4*)(lb + col);
#pragma unroll
                    for (int ai = 0; ai < 2; ++ai)
#pragma unroll
                        for (int m = 0; m < 4; ++m) { const pg8::f32x4 v = acc[ai][bj][m][n]; typedef _Float16 h4_t __attribute__((ext_vector_type(4))); h4_t hv;
#pragma unroll
                            for (int j = 0; j < 4; ++j) hv[j] = (_Float16)__logf(l[j] + (1.0f - l[j]) * __builtin_amdgcn_rcpf(1.0f + __expf(-v[j])));
                            *(u32x2_t*)(PF + (size_t)(row0 + ai * 128 + m * 16) * 1024 + col) = __builtin_bit_cast(u32x2_t, hv); }
                }
        } else {
            if (ct < 2 && u.pm >= 64) return;
            pg8::bf16_t* O = (pg8::bf16_t*)(ws + (ct < 2 ? WS_PU : (ct < 4 ? RC_PQ : (ct < 6 ? RC_PV : RC_PG))));
#pragma unroll
            for (int bj = 0; bj < 2; ++bj)
#pragma unroll
                for (int n = 0; n < 2; ++n) {
                    const int col = colw + bj * 128 + n * 16;
#pragma unroll
                    for (int ai = 0; ai < 2; ++ai)
#pragma unroll
                        for (int m = 0; m < 4; ++m) { pg8::f32x4 v = acc[ai][bj][m][n];
                            if (ct == 2 || ct == 3) {
#pragma unroll
                                for (int j = 0; j < 4; ++j) v[j] = v[j] * __builtin_amdgcn_rcpf(1.0f + __expf(-v[j])); }
                            u32x2_t w; w.x = pg8::cvt_pk_bf16(v[0], v[1]); w.y = pg8::cvt_pk_bf16(v[2], v[3]);
                            *(u32x2_t*)(O + (size_t)(row0 + ai * 128 + m * 16) * 512 + col) = w; }
                }
        }
    }
};
struct EpiWout {
    static constexpr bool PERM = false;
    _Float16* X1; const float* x; const float* mod;
    __device__ __forceinline__ void operator()(const pg8::f32x4 (&acc)[2][2][4][2], const pg8::Unit& u, int wr, int wc, int fr, int fq) const {
        const int row0 = u.pm * 256 + wr * 64 + fr, col0 = u.pn * 256 + wc * 32 + 4 * fq; const float* gt = mod + (u.pm >> 5) * 6144 + 2048;
#pragma unroll
        for (int bj = 0; bj < 2; ++bj)
#pragma unroll
            for (int n = 0; n < 2; ++n) {
                const int col = col0 + bj * 128 + n * 16; const pg8::f32x4 g = *(const pg8::f32x4*)(gt + col);
#pragma unroll
                for (int ai = 0; ai < 2; ++ai)
#pragma unroll
                    for (int m = 0; m < 4; ++m) { const size_t o = (size_t)(row0 + ai * 128 + m * 16) * D_ + col; const pg8::f32x4 v = *(const pg8::f32x4*)(x + o) + g * acc[ai][bj][m][n];
                        h4v_t hv; hv[0] = (_Float16)v[0]; hv[1] = (_Float16)v[1]; hv[2] = (_Float16)v[2]; hv[3] = (_Float16)v[3]; *(h4v_t*)(X1 + o) = hv; }
            }
    }
};
struct SchedGU {
    int G, c;
    __device__ bool next(int i, pg8::Unit& u) const {
        const int L = i * G + c; if (L >= 2816) return false;
        const int r = L >> 8, cc = L & 255, xcd = cc & 7, j = cc >> 3, mt = j & 7, ntl = j >> 3, q = (r * 8 + xcd) * 4 + ntl, e = q / 22;
        u.pm = e * 8 + mt; u.pn = q; return true;
    }
};
struct SchedDown {
    int G, c;
    __device__ bool next(int i, pg8::Unit& u) const {
        const int L = i * G + c; if (L >= 512) return false;
        const int r = L >> 8, cc = L & 255, xcd = cc & 7, j = cc >> 3, mt = j & 7, nt = j >> 3, e = r * 8 + xcd;
        u.pm = e * 8 + mt; u.pn = e * 4 + nt; return true;
    }
};
__device__ __forceinline__ unsigned pk4_fp8(float a, float b, float c, float d) { unsigned w = 0u; w = __builtin_amdgcn_cvt_pk_fp8_f32(a, b, w, false); w = __builtin_amdgcn_cvt_pk_fp8_f32(c, d, w, true); return w; }
struct EpiGU {
    static constexpr bool PERM = true;
    unsigned char* HID;
    __device__ __forceinline__ void operator()(const pg8::f32x4 (&acc)[2][2][4][2], const pg8::Unit& u, int wr, int wc, int fr, int fq) const {
        const int row0 = u.pm * 256 + wr * 64 + fr, col0 = (u.pn % 22) * 128 + wc * 32 + 8 * fq;
#pragma unroll
        for (int ai = 0; ai < 2; ++ai)
#pragma unroll
            for (int m = 0; m < 4; ++m) {
                float h[8];
#pragma unroll
                for (int n = 0; n < 2; ++n)
#pragma unroll
                    for (int j = 0; j < 4; ++j) { const float gv = acc[ai][0][m][n][j], uv = acc[ai][1][m][n][j]; h[n * 4 + j] = __builtin_amdgcn_fmed3f(gv * __builtin_amdgcn_rcpf(1.0f + __expf(-gv)) * uv * 8.0f, -448.0f, 448.0f); }
                u32x2_t w; w.x = pk4_fp8(h[0], h[1], h[2], h[3]); w.y = pk4_fp8(h[4], h[5], h[6], h[7]);
                *(u32x2_t*)(HID + (size_t)(row0 + ai * 128 + m * 16) * DE_ + col0) = w;
            }
    }
};
struct EpiDown {
    static constexpr bool PERM = true;
    pg8::bf16_t* YE; const float* GATER;
    __device__ __forceinline__ void operator()(const pg8::f32x4 (&acc)[2][2][4][2], const pg8::Unit& u, int wr, int wc, int fr, int fq) const {
        const int row0 = u.pm * 256 + wr * 64 + fr, col0 = (u.pn & 3) * 256 + wc * 32 + 8 * fq;
#pragma unroll
        for (int ai = 0; ai < 2; ++ai)
#pragma unroll
            for (int m = 0; m < 4; ++m) {
                const int row = row0 + ai * 128 + m * 16; const float gt = GATER[row];
#pragma unroll
                for (int bj = 0; bj < 2; ++bj) { const pg8::f32x4 v0 = acc[ai][bj][m][0] * gt, v1 = acc[ai][bj][m][1] * gt;
                    pg8::u32x4 w; w.x = pg8::cvt_pk_bf16(v0[0], v0[1]); w.y = pg8::cvt_pk_bf16(v0[2], v0[3]); w.z = pg8::cvt_pk_bf16(v1[0], v1[1]); w.w = pg8::cvt_pk_bf16(v1[2], v1[3]);
                    *(pg8::u32x4*)(YE + (size_t)row * D_ + col0 + bj * 128) = w; }
            }
    }
};

template <class RowFn>
__device__ __forceinline__ void transpose_item(const float* W, int N, int k0, int n0, const RowFn& dst, PG8_LAS unsigned* scr, int lane) {
    const int r = lane >> 4, n4 = lane & 15;
    float4 v[16];
#pragma unroll
    for (int i = 0; i < 16; ++i) { const int k = 8 * (i >> 1) + 2 * r + (i & 1); v[i] = *(const float4*)(W + (size_t)(k0 + k) * N + n0 + n4 * 4); }
#pragma unroll
    for (int j = 0; j < 8; ++j) {
        const int kp = 4 * j + r; PG8_LAS unsigned* t = scr + (n4 * 4) * 33 + kp;
        t[0] = pg8::cvt_pk_bf16(v[2 * j].x, v[2 * j + 1].x); t[33] = pg8::cvt_pk_bf16(v[2 * j].y, v[2 * j + 1].y);
        t[66] = pg8::cvt_pk_bf16(v[2 * j].z, v[2 * j + 1].z); t[99] = pg8::cvt_pk_bf16(v[2 * j].w, v[2 * j + 1].w);
    }
    asm volatile("s_waitcnt lgkmcnt(0)" ::: "memory");
    const int c8 = lane & 7;
#pragma unroll
    for (int jj = 0; jj < 8; ++jj) {
        const int n = (lane >> 3) + 8 * jj; const PG8_LAS unsigned* t = scr + n * 33 + 4 * c8;
        uint4 o; o.x = t[0]; o.y = t[1]; o.z = t[2]; o.w = t[3];
        *(uint4*)(dst(n0 + n) + k0 + 8 * c8) = o;
    }
    asm volatile("s_waitcnt lgkmcnt(0)" ::: "memory");
}
struct RowGU { pg8::bf16_t* base; int up; __device__ pg8::bf16_t* operator()(int f) const { return base + ((size_t)(f >> 7) * 256 + up * 128 + (f & 127)) * 1024; } };
struct RowPlain { pg8::bf16_t* base; int K; __device__ pg8::bf16_t* operator()(int n) const { return base + (size_t)n * K; } };
struct CvItem { const float* W; unsigned char* base; int N, k0, n0, A, Kd; };
struct CvSrc { const float *wg, *wu, *wd; unsigned char *wgu, *wdt; };
__device__ __forceinline__ CvItem moe_item(const CvSrc q, int it) {
    constexpr int IG = 16 * 44, ID = 44 * 16;
    const int e = it / (2 * IG + ID), r = it - e * (2 * IG + ID);
    const bool isd = r >= 2 * IG, up = (r >= IG) && !isd;
    const int r2 = r - (isd ? 2 * IG : (up ? IG : 0));
    const int kbg = r2 / 44, nbg = r2 - kbg * 44, kbd = r2 >> 4, nbd = r2 & 15;
    CvItem c;
    const float* wsel = isd ? q.wd : (up ? q.wu : q.wg);
    c.W = wsel + (size_t)e * D_ * DE_;
    c.N = isd ? D_ : DE_; c.k0 = (isd ? kbd : kbg) * 64; c.n0 = (isd ? nbd : nbg) * 64;
    c.base = (isd ? q.wdt : q.wgu) + (isd ? (size_t)e * 1024 * DE_ : ((size_t)e * 22 * 256 + (up ? 128 : 0)) * 1024);
    c.A = isd ? 128 : 256; c.Kd = isd ? DE_ : 1024;
    return c;
}
__device__ __forceinline__ void cv_load(const CvItem& c, pg8::f32x4 (&v)[16], int lane) {
    const int r = lane >> 4, n4 = lane & 15;
#pragma unroll
    for (int i = 0; i < 16; ++i) { const int k = 16 * (i >> 2) + 4 * r + (i & 3); v[i] = __builtin_nontemporal_load((const pg8::f32x4*)(c.W + (size_t)(c.k0 + k) * c.N + c.n0 + n4 * 4)); }
}
__device__ __forceinline__ void cv_store(const CvItem& c, const pg8::f32x4 (&v)[16], PG8_LAS unsigned* scr, int lane) {
    const int r = lane >> 4, n4 = lane & 15;
#pragma unroll
    for (int j = 0; j < 4; ++j) {
        PG8_LAS unsigned* t = scr + (n4 * 4) * 17 + 4 * j + r;
#pragma unroll
        for (int cc = 0; cc < 4; ++cc) t[17 * cc] = pk4_fp8(__builtin_amdgcn_fmed3f(v[4 * j][cc] * 64.0f, -448.f, 448.f), __builtin_amdgcn_fmed3f(v[4 * j + 1][cc] * 64.0f, -448.f, 448.f), __builtin_amdgcn_fmed3f(v[4 * j + 2][cc] * 64.0f, -448.f, 448.f), __builtin_amdgcn_fmed3f(v[4 * j + 3][cc] * 64.0f, -448.f, 448.f));
    }
    asm volatile("s_waitcnt lgkmcnt(0)" ::: "memory");
    const int c4 = lane & 3;
#pragma unroll
    for (int jj = 0; jj < 4; ++jj) {
        const int n = (lane >> 2) + 16 * jj, nn = c.n0 + n; const PG8_LAS unsigned* t = scr + n * 17 + 4 * c4;
        pg8::u32x4 o; o.x = t[0]; o.y = t[1]; o.z = t[2]; o.w = t[3];
        __builtin_nontemporal_store(o, (pg8::u32x4*)(c.base + ((size_t)(nn >> 7) * c.A + (nn & 127)) * c.Kd + c.k0 + 16 * c4));
    }
    asm volatile("s_waitcnt lgkmcnt(0)" ::: "memory");
}
__device__ void st_convert_moe(KP p, PG8_LAS unsigned* ldsw, int bid, int nb) {
    const int tidx_ = ltid();
    const int lane = tidx_ & 63, wv = __builtin_amdgcn_readfirstlane(tidx_ >> 6), gw = bid * 8 + wv, nw = nb * 8;
    PG8_LAS unsigned* scr = ldsw + wv * 2112;
    constexpr int NIT = 16 * 3 * 704;
    if (gw >= NIT) return;
    const CvSrc cs{p->w_g, p->w_u, p->w_d, p->ws + WS_WGU, p->ws + WS_WD};
    pg8::f32x4 va[16], vb[16];
    CvItem ca = moe_item(cs, gw); cv_load(ca, va, lane);
    for (int it = gw; it < NIT; it += 2 * nw) {
        const int itb = it + nw, itbc = itb < NIT ? itb : it;
        const CvItem cb = moe_item(cs, itbc); cv_load(cb, vb, lane);
        cv_store(ca, va, scr, lane);
        const int ita = itb + nw, itac = ita < NIT ? ita : it;
        ca = moe_item(cs, itac); cv_load(ca, va, lane);
        if (itb < NIT) cv_store(cb, vb, scr, lane);
    }
}
__device__ void st_convert_dense(KP p, PG8_LAS unsigned* ldsw, int bid, int nb) {
    const int tidx_ = ltid();
    const int lane = tidx_ & 63, wv = tidx_ >> 6, gw = bid * 8 + wv, nw = nb * 8;
    PG8_LAS unsigned* scr = ldsw + wv * 2112;
    constexpr int II = 16 * 48, IO = 16 * 16;
    for (int it = gw; it < II + IO; it += nw) {
        if (it < II) { RowPlain fn{(pg8::bf16_t*)(p->ws + WS_WINT), D_}; transpose_item(p->w_in, DIN_, (it / 48) * 64, (it % 48) * 64, fn, scr, lane); }
        else { const int r = it - II; RowPlain fn{(pg8::bf16_t*)(p->ws + WS_WOUTT), D_}; transpose_item(p->w_out, D_, (r / 16) * 64, (r % 16) * 64, fn, scr, lane); }
    }
}
__device__ void st_gather(KP p, int bid, int nb) {
    const int tidx_ = ltid();
    const int* IDXR = (const int*)(p->ws + WS_IDX); const uint4* H2B = (const uint4*)(p->ws + RC_H2B); uint4* XS = (uint4*)(p->ws + RC_XS);
    const int lane = tidx_ & 63, gw = bid * 8 + (tidx_ >> 6), nw = nb * 8;
    for (int row = gw; row < 32768; row += nw) {
        const int e = row >> 11, bb = (row >> 10) & 1, c = row & 1023; const int t = IDXR[(bb * 16 + e) * 1024 + c];
        XS[(size_t)row * 64 + lane] = H2B[(size_t)(bb * L_ + t) * 64 + lane];
    }
}


__device__ __forceinline__ pg8::bf16_t f2bf(float v) { return (pg8::bf16_t)(pg8::cvt_pk_bf16(v, 0.f) & 0xffffu); }
__device__ void st_dft_consts(KP p, PG8_LAS float* tc, int bid, int nb) {
    const int tidx_ = ltid();
    pg8::bf16_t* W12T = (pg8::bf16_t*)(p->ws + WS_W12T); pg8::bf16_t* FA = (pg8::bf16_t*)(p->ws + WS_FA); pg8::bf16_t* FC = (pg8::bf16_t*)(p->ws + WS_FC);
    const int gt = bid * 512 + tidx_, nt = nb * 512;
    __syncthreads();
    if (tidx_ < 128) { tc[tidx_] = cospif((float)tidx_ / 64.0f); tc[128 + tidx_] = sinpif((float)tidx_ / 64.0f); }
    __syncthreads();
    for (int i = gt; i < 4 * 256 * 128; i += nt) {
        const int g = i >> 15, r = (i >> 7) & 255, c = i & 127, d = r & 127, to = r < 128 ? 0 : 128; float acc = 0.f;
        for (int m = 0; m < 128; ++m) acc = fmaf(tc[to + ((m * c) & 127)], p->w_f[(g * 128 + m) * 128 + d], acc);
        W12T[i] = f2bf(r < 128 ? acc : -acc);
    }
    for (int i = gt; i < 256 * 256; i += nt) {
        const int r = i >> 8, kk = i & 255, k1 = r & 127, l1 = kk >> 1, im_in = kk & 1, a = (k1 * l1) & 127;
        const float C = tc[a], S = tc[128 + a]; float v;
        if (r < 128) v = im_in ? S : C; else v = im_in ? C : -S;
        FA[i] = f2bf(v * (1.0f / 16.0f));
    }
    for (int i = gt; i < 64 * 128; i += nt) {
        const int k2 = i >> 7, kk = i & 127, l2 = kk >> 1, a = ((k2 * l2) & 63) * 2;
        FC[i] = f2bf(((kk & 1) ? tc[128 + a] : tc[a]) * (1.0f / 64.0f));
    }
    __syncthreads();
}
__device__ __forceinline__ pg8::bf16x8 ld16(const pg8::bf16_t* q) { return *(const pg8::bf16x8*)q; }
__device__ void st_dft0(KP p, PG8_LAS unsigned char* lds, int bid, int nb) {
    const int tidx_ = ltid();
    const pg8::bf16_t* PU = (const pg8::bf16_t*)(p->ws + WS_PU); const pg8::bf16_t* W12T = (const pg8::bf16_t*)(p->ws + WS_W12T); unsigned* X = (unsigned*)(p->ws + RC_XF);
    const int lane = tidx_ & 63, wv = tidx_ >> 6, n = lane & 15, q = lane >> 4;
    for (int grp = bid; grp < 256; grp += nb) {
        const int g = grp >> 6, b = (grp >> 5) & 1, l2b = (grp & 31) * 2;
        pg8::u32x4 st[8];
#pragma unroll
        for (int i = 0; i < 8; ++i) { const int pc = tidx_ + 512 * i, row = pc >> 4, c16 = pc & 15, it = row >> 4, tn = row & 15, l2 = l2b + (it >> 3), l1t = it & 7;
            st[i] = *(const pg8::u32x4*)(PU + ((size_t)(b * L_ + 64 * (l1t * 16 + tn) + l2)) * 512 + g * 128 + c16 * 8); }
        pg8::bf16x8 Fre[4], Fim[4];
#pragma unroll
        for (int ks = 0; ks < 4; ++ks) { Fre[ks] = ld16(W12T + ((size_t)(g * 256 + 16 * wv + n)) * 128 + ks * 32 + 8 * q); Fim[ks] = ld16(W12T + ((size_t)(g * 256 + 128 + 16 * wv + n)) * 128 + ks * 32 + 8 * q); }
        __syncthreads();
#pragma unroll
        for (int i = 0; i < 8; ++i) { const int pc = tidx_ + 512 * i; *(PG8_LAS pg8::u32x4*)(lds + (pc >> 4) * 272 + (pc & 15) * 16) = st[i]; }
        __syncthreads();
#pragma unroll 2
        for (int it = 0; it < 16; ++it) {
            const int l2 = l2b + (it >> 3), l1t = it & 7;
            pg8::f32x4 ar = (pg8::f32x4){0.f, 0.f, 0.f, 0.f}, ai = ar;
#pragma unroll
            for (int ks = 0; ks < 4; ++ks) { const pg8::bf16x8 bf = *(const PG8_LAS pg8::bf16x8*)(lds + (it * 16 + n) * 272 + (ks * 32 + 8 * q) * 2);
                ar = __builtin_amdgcn_mfma_f32_16x16x32_bf16(Fre[ks], bf, ar, 0, 0, 0); ai = __builtin_amdgcn_mfma_f32_16x16x32_bf16(Fim[ks], bf, ai, 0, 0, 0); }
#pragma unroll
            for (int r = 0; r < 4; ++r) { const int d = 16 * wv + 4 * q + r; X[((size_t)((b * 64 + l2) * 512 + g * 128 + d)) * 128 + l1t * 16 + n] = pg8::cvt_pk_bf16(ar[r], ai[r]); }
        }
    }
    __syncthreads();
}
__device__ void st_dftA(KP p, PG8_LAS unsigned char* lds, int bid, int nb) {
    const int tidx_ = ltid();
    const pg8::bf16_t* X = (const pg8::bf16_t*)(p->ws + RC_XF); const pg8::bf16_t* FA = (const pg8::bf16_t*)(p->ws + WS_FA); const float* CS = (const float*)(p->ws + WS_COS); unsigned* Y = (unsigned*)(p->ws + RC_YF);
    const int lane = tidx_ & 63, wv = tidx_ >> 6, n = lane & 15, q = lane >> 4;
    pg8::bf16x8 Fre[8], Fim[8];
#pragma unroll
    for (int ks = 0; ks < 8; ++ks) { Fre[ks] = ld16(FA + (size_t)(16 * wv + n) * 256 + ks * 32 + 8 * q); Fim[ks] = ld16(FA + (size_t)(128 + 16 * wv + n) * 256 + ks * 32 + 8 * q); }
    for (int grp = bid; grp < 256; grp += nb) {
        const int l2t = grp >> 6, b = (grp >> 5) & 1, gd0 = (grp & 31) * 16, l2 = l2t * 16 + n;
        float ct[4], st[4];
#pragma unroll
        for (int r = 0; r < 4; ++r) { const int idx = (16 * wv + 4 * q + r) * l2; ct[r] = CS[idx]; st[r] = CS[(idx - 2048) & 8191]; }
        pg8::u32x4 sg[8];
#pragma unroll
        for (int i = 0; i < 8; ++i) { const int pc = tidx_ + 512 * i, row = pc >> 5, c16 = pc & 31;
            sg[i] = *(const pg8::u32x4*)(X + ((size_t)((b * 64 + l2t * 16 + (row & 15)) * 512 + gd0 + (row >> 4))) * 256 + c16 * 8); }
#pragma unroll 1
        for (int half = 0; half < 2; ++half) {
            __syncthreads();
#pragma unroll
            for (int i = 0; i < 8; ++i) { const int pc = tidx_ + 512 * i; *(PG8_LAS pg8::u32x4*)(lds + (pc >> 5) * 528 + (pc & 31) * 16) = sg[i]; }
            __syncthreads();
            if (half == 0) {
#pragma unroll
                for (int i = 0; i < 8; ++i) { const int pc = tidx_ + 512 * i, row = pc >> 5, c16 = pc & 31;
                    sg[i] = *(const pg8::u32x4*)(X + ((size_t)((b * 64 + l2t * 16 + (row & 15)) * 512 + gd0 + 8 + (row >> 4))) * 256 + c16 * 8); }
            }
#pragma unroll 2
            for (int gi = 0; gi < 8; ++gi) {
                const int gd = gd0 + half * 8 + gi;
                pg8::f32x4 ar = (pg8::f32x4){0.f, 0.f, 0.f, 0.f}, ai = ar;
#pragma unroll
                for (int ks = 0; ks < 8; ++ks) { const pg8::bf16x8 bf = *(const PG8_LAS pg8::bf16x8*)(lds + (gi * 16 + n) * 528 + (ks * 32 + 8 * q) * 2);
                    ar = __builtin_amdgcn_mfma_f32_16x16x32_bf16(Fre[ks], bf, ar, 0, 0, 0); ai = __builtin_amdgcn_mfma_f32_16x16x32_bf16(Fim[ks], bf, ai, 0, 0, 0); }
#pragma unroll
                for (int r = 0; r < 4; ++r) { const int k1 = 16 * wv + 4 * q + r; const float yr = ar[r] * ct[r] + ai[r] * st[r], yi = ai[r] * ct[r] - ar[r] * st[r];
                    Y[((size_t)((b * 128 + k1) * 512 + gd)) * 64 + l2] = pg8::cvt_pk_bf16(yr, yi); }
            }
        }
    }
    __syncthreads();
}
__device__ void st_dftC(KP p, int bid, int nb) {
    const int tidx_ = ltid();
    const pg8::bf16_t* Y = (const pg8::bf16_t*)(p->ws + RC_YF); const pg8::bf16_t* FC = (const pg8::bf16_t*)(p->ws + WS_FC); pg8::bf16_t* MIX = (pg8::bf16_t*)(p->ws + RC_MIX);
    const int lane = tidx_ & 63, wv = tidx_ >> 6, n = lane & 15, q = lane >> 4, gw = bid * 8 + wv, nw = nb * 8;
    pg8::bf16x8 F[4][4];
#pragma unroll
    for (int mt = 0; mt < 4; ++mt)
#pragma unroll
        for (int ks = 0; ks < 4; ++ks) F[mt][ks] = ld16(FC + (size_t)(16 * mt + n) * 128 + ks * 32 + 8 * q);
    for (int t0 = gw * 2; t0 < 8192; t0 += nw * 2) {
        pg8::bf16x8 Bf[2][4];
#pragma unroll
        for (int i = 0; i < 2; ++i) { const int t = t0 + i; const pg8::bf16_t* row = Y + ((size_t)((t >> 3) * 128 + (t & 7) * 16 + n)) * 128 + 8 * q;
#pragma unroll
            for (int ks = 0; ks < 4; ++ks) Bf[i][ks] = ld16(row + ks * 32); }
#pragma unroll
        for (int i = 0; i < 2; ++i) { const int t = t0 + i, bk = t >> 5, g = (t >> 3) & 3, d = (t & 7) * 16 + n, b = bk >> 7, k1 = bk & 127;
#pragma unroll
            for (int mt = 0; mt < 4; ++mt) { pg8::f32x4 a = (pg8::f32x4){0.f, 0.f, 0.f, 0.f};
#pragma unroll
                for (int ks = 0; ks < 4; ++ks) a = __builtin_amdgcn_mfma_f32_16x16x32_bf16(F[mt][ks], Bf[i][ks], a, 0, 0, 0);
#pragma unroll
                for (int r = 0; r < 4; ++r) { const int k = k1 + 128 * (16 * mt + 4 * q + r); MIX[((size_t)(b * L_ + k)) * D_ + g * 128 + d] = f2bf(a[r]); } } }
    }
}


constexpr int SC_T = 0, SC_GX = 2048, SC_QH = 4096, SC_QT = 21504, SC_KH = 38912, SC_KT = 82432, SC_VT = 100864, SC_A = 119296, SC_RS = 272, SC_RS64 = 144;
template <bool OUT>
__device__ __forceinline__ void scan_task(unsigned char* wsb, PG8_LAS unsigned char* lds, int dir, int b, int h, bool ctx, int pos0, int nch, pg8::f32x4 (&S)[8], float& glog, pg8::bf16_t* O) {
    const int tidx_ = ltid();
    const int tid = tidx_, ch = tid & 127, J = tid >> 7, lane = tid & 63, w = tid >> 6, r = lane & 15, quad = lane >> 4;
    PG8_LAS float* T = (PG8_LAS float*)(lds + SC_T); PG8_LAS float* GX = (PG8_LAS float*)(lds + SC_GX);
    if (OUT) {
        if (tid < 128) { const int blk = tid >> 6, rr = (tid >> 2) & 15, cc = tid & 3; *(PG8_LAS unsigned long long*)(lds + SC_A + (32 * blk + rr) * SC_RS64 + (32 * blk + 16 + 4 * cc) * 2) = 0ull; }
    }
    const int koff = (J == 0) ? 0 : (J == 1 ? 16 : (J == 2 ? 48 : 96));
    float lf[16]; unsigned vr[16], qr[16];
#define SCAN_LOADS(cc, LF, VR, QR) do { _Pragma("unroll") for (int ii = 0; ii < 16; ++ii) { \
        const int pos = pos0 + 64 * (cc) + 16 * J + ii; \
        const int row = ctx ? (RL_ + b * CTX_ + (dir ? CTX_ - 1 - pos : pos)) : (b * L_ + (dir ? L_ - 1 - pos : pos)); \
        LF[ii] = (float)((const _Float16*)(wsb + RC_PF))[(size_t)row * 1024 + dir * 512 + h * 128 + ch]; \
        VR[ii] = ((const pg8::bf16_t*)(wsb + RC_PV))[(size_t)row * 512 + h * 128 + ch]; \
        if (OUT) QR[ii] = ((const pg8::bf16_t*)(wsb + RC_PQ))[(size_t)row * 512 + h * 128 + ch]; } } while (0)
    SCAN_LOADS(0, lf, vr, qr);
    for (int c = 0; c < nch; ++c) {
        float qv[16], vv[16];
#pragma unroll
        for (int ii = 0; ii < 16; ++ii) { vv[ii] = __uint_as_float(vr[ii] << 16); if (OUT) qv[ii] = __uint_as_float(qr[ii] << 16); }
        float cs[16]; float run = 0.f;
#pragma unroll
        for (int ii = 0; ii < 16; ++ii) { run += lf[ii]; cs[ii] = run; lf[ii] = 1.f - __expf(lf[ii]); }
        T[J * 128 + ch] = run;
        __syncthreads();
        const float t0 = T[ch], t1 = T[128 + ch], t2 = T[256 + ch], t3 = T[384 + ch];
        const float ref1 = t0, ref2 = t0 + t1, ref3 = ref2 + t2, gtot = ref3 + t3;
        const float myref = (J == 0) ? 0.f : (J == 1 ? ref1 : (J == 2 ? ref2 : ref3));
        if (J == 0) GX[ch] = __expf(gtot);
        const float gprev = glog;
        glog += gtot;
        {
            unsigned pv[8], pk[8]; const float eg = gtot - myref;
#pragma unroll
            for (int i2 = 0; i2 < 8; ++i2) {
                pv[i2] = pg8::cvt_pk_bf16(vv[2 * i2], vv[2 * i2 + 1]);
                pk[i2] = pg8::cvt_pk_bf16(lf[2 * i2] * __expf(eg - cs[2 * i2]), lf[2 * i2 + 1] * __expf(eg - cs[2 * i2 + 1]));
            }
            PG8_LAS pg8::u32x4* dv = (PG8_LAS pg8::u32x4*)(lds + SC_VT + ch * SC_RS64 + 32 * J); dv[0] = (pg8::u32x4){pv[0], pv[1], pv[2], pv[3]}; dv[1] = (pg8::u32x4){pv[4], pv[5], pv[6], pv[7]};
            PG8_LAS pg8::u32x4* dk = (PG8_LAS pg8::u32x4*)(lds + SC_KT + ch * SC_RS64 + 32 * J); dk[0] = (pg8::u32x4){pk[0], pk[1], pk[2], pk[3]}; dk[1] = (pg8::u32x4){pk[4], pk[5], pk[6], pk[7]};
        }
        if (OUT) {
            const float eJ = __expf(myref), eG = __expf(gprev + myref);
            const float x1 = (J < 1) ? __expf(ref1 - myref) : 0.f, x2 = (J < 2) ? __expf(ref2 - myref) : 0.f, x3 = (J < 3) ? __expf(ref3 - myref) : 0.f;
#pragma unroll
            for (int ii = 0; ii < 16; ++ii) {
                const float cc = fmaxf(cs[ii], -80.f), qh = qv[ii] * __expf(cc), kd = lf[ii] * __expf(-cc); const int j = 16 * J + ii;
                { const int pos = pos0 + 64 * c + j; const int row = b * L_ + (dir ? L_ - 1 - pos : pos);
                  ((pg8::bf16_t*)(wsb + RC_PF))[(size_t)row * 1024 + dir * 512 + h * 128 + ch] = f2bf(qh * eG); }
                *(PG8_LAS pg8::bf16_t*)(lds + SC_QH + j * SC_RS + ch * 2) = f2bf(qh);
                *(PG8_LAS pg8::bf16_t*)(lds + SC_QT + j * SC_RS + ch * 2) = f2bf(qh * eJ);
                *(PG8_LAS pg8::bf16_t*)(lds + SC_KH + (koff + j) * SC_RS + ch * 2) = f2bf(kd);
                if (J < 1) *(PG8_LAS pg8::bf16_t*)(lds + SC_KH + (16 + j) * SC_RS + ch * 2) = f2bf(kd * x1);
                if (J < 2) *(PG8_LAS pg8::bf16_t*)(lds + SC_KH + (48 + j) * SC_RS + ch * 2) = f2bf(kd * x2);
                if (J < 3) *(PG8_LAS pg8::bf16_t*)(lds + SC_KH + (96 + j) * SC_RS + ch * 2) = f2bf(kd * x3);
            }
        }
        __syncthreads();
        float lfn[16]; unsigned vrn[16], qrn[16];
        { const int cn = c + 1 < nch ? c + 1 : c; SCAN_LOADS(cn, lfn, vrn, qrn); }
        pg8::bf16x8 vb[2];
#pragma unroll
        for (int ks = 0; ks < 2; ++ks) vb[ks] = *(const PG8_LAS pg8::bf16x8*)(lds + SC_VT + (16 * w + r) * SC_RS64 + (32 * ks + 8 * quad) * 2);
        pg8::f32x4 oacc[4];
        if (OUT) {
            for (int tile = w; tile < 10; tile += 8) {
                const int Jt = (tile < 1) ? 0 : (tile < 3 ? 1 : (tile < 6 ? 2 : 3)), Js = tile - ((Jt * (Jt + 1)) >> 1), kb = (Jt == 0) ? 0 : (Jt == 1 ? 16 : (Jt == 2 ? 48 : 96));
                pg8::f32x4 a = (pg8::f32x4){0.f, 0.f, 0.f, 0.f};
#pragma unroll
                for (int ks = 0; ks < 4; ++ks) {
                    const pg8::bf16x8 ka = *(const PG8_LAS pg8::bf16x8*)(lds + SC_KH + (kb + 16 * Js + r) * SC_RS + (32 * ks + 8 * quad) * 2);
                    const pg8::bf16x8 qb = *(const PG8_LAS pg8::bf16x8*)(lds + SC_QH + (16 * Jt + r) * SC_RS + (32 * ks + 8 * quad) * 2);
                    a = __builtin_amdgcn_mfma_f32_16x16x32_bf16(ka, qb, a, 0, 0, 0);
                }
                if (Jt == Js) {
#pragma unroll
                    for (int rr = 0; rr < 4; ++rr) a[rr] = (4 * quad + rr <= r) ? a[rr] : 0.f;
                }
                u32x2_t pa; pa.x = pg8::cvt_pk_bf16(a[0], a[1]); pa.y = pg8::cvt_pk_bf16(a[2], a[3]);
                *(PG8_LAS u32x2_t*)(lds + SC_A + (16 * Jt + r) * SC_RS64 + (16 * Js + 4 * quad) * 2) = pa;
            }
#pragma unroll
            for (int it = 0; it < 4; ++it) oacc[it] = (pg8::f32x4){0.f, 0.f, 0.f, 0.f};
#pragma unroll
            for (int s2 = 0; s2 < 4; ++s2) {
                union { unsigned u[4]; pg8::bf16x8 v; } sb;
                sb.u[0] = pg8::cvt_pk_bf16(S[2 * s2][0], S[2 * s2][1]); sb.u[1] = pg8::cvt_pk_bf16(S[2 * s2][2], S[2 * s2][3]);
                sb.u[2] = pg8::cvt_pk_bf16(S[2 * s2 + 1][0], S[2 * s2 + 1][1]); sb.u[3] = pg8::cvt_pk_bf16(S[2 * s2 + 1][2], S[2 * s2 + 1][3]);
#pragma unroll
                for (int it = 0; it < 4; ++it) {
                    union { u32x2_t h[2]; pg8::bf16x8 v; } qa;
                    qa.h[0] = *(const PG8_LAS u32x2_t*)(lds + SC_QT + (16 * it + r) * SC_RS + (32 * s2 + 4 * quad) * 2);
                    qa.h[1] = *(const PG8_LAS u32x2_t*)(lds + SC_QT + (16 * it + r) * SC_RS + (32 * s2 + 16 + 4 * quad) * 2);
                    oacc[it] = __builtin_amdgcn_mfma_f32_16x16x32_bf16(qa.v, sb.v, oacc[it], 0, 0, 0);
                }
            }
            __syncthreads();
#pragma unroll
            for (int it = 0; it < 4; ++it)
#pragma unroll
                for (int ks = 0; ks < 2; ++ks) {
                    if (ks == 1 && it < 2) continue;
                    const pg8::bf16x8 aa = *(const PG8_LAS pg8::bf16x8*)(lds + SC_A + (16 * it + r) * SC_RS64 + (32 * ks + 8 * quad) * 2);
                    oacc[it] = __builtin_amdgcn_mfma_f32_16x16x32_bf16(aa, vb[ks], oacc[it], 0, 0, 0);
                }
#pragma unroll
            for (int it = 0; it < 4; ++it)
#pragma unroll
                for (int rr = 0; rr < 4; ++rr) { const int pos = pos0 + 64 * c + 16 * it + 4 * quad + rr; const int t = dir ? L_ - 1 - pos : pos;
                    O[(size_t)(b * L_ + t) * 512 + h * 128 + 16 * w + r] = f2bf(oacc[it][rr]); }
        }
#pragma unroll
        for (int t = 0; t < 8; ++t) { const pg8::f32x4 gx = *(const PG8_LAS pg8::f32x4*)(lds + SC_GX + (16 * t + 4 * quad) * 4); S[t] = S[t] * gx; }
#pragma unroll
        for (int t = 0; t < 8; ++t)
#pragma unroll
            for (int ks = 0; ks < 2; ++ks) {
                const pg8::bf16x8 ka = *(const PG8_LAS pg8::bf16x8*)(lds + SC_KT + (16 * t + r) * SC_RS64 + (32 * ks + 8 * quad) * 2);
                S[t] = __builtin_amdgcn_mfma_f32_16x16x32_bf16(ka, vb[ks], S[t], 0, 0, 0);
            }
        __syncthreads();
#pragma unroll
        for (int ii = 0; ii < 16; ++ii) { lf[ii] = lfn[ii]; vr[ii] = vrn[ii]; if (OUT) qr[ii] = qrn[ii]; }
    }
#undef SCAN_LOADS
}
__device__ void st_scan1(KP p, PG8_LAS unsigned char* lds, int bid, int nb) {
    const int tidx_ = ltid();
    unsigned char* P = p->ws; float* USEG = (float*)(p->ws + RC_USEG); float* GSEG = (float*)(p->ws + RC_GSEG);
    const int tid = tidx_, lane = tid & 63, w = tid >> 6;
    for (int task = bid; task < 320; task += nb) {
        const bool ctx = task >= 256; const int chain = ctx ? (task - 256) >> 2 : task >> 4, seg = ctx ? (task & 3) : (task & 15), dir = chain >> 3, b = (chain >> 2) & 1, h = chain & 3;
        pg8::f32x4 S[8]; float glog = 0.f;
#pragma unroll
        for (int t = 0; t < 8; ++t) S[t] = (pg8::f32x4){0.f, 0.f, 0.f, 0.f};
        if (ctx) scan_task<false>(P, lds, dir, b, h, true, 64 * seg, 1, S, glog, nullptr);
        else scan_task<true>(P, lds, dir, b, h, false, 512 * seg, 8, S, glog, (pg8::bf16_t*)(p->ws + (dir ? RC_OB : RC_OF)));
#pragma unroll
        for (int t = 0; t < 8; ++t)
#pragma unroll
            for (int rr = 0; rr < 4; ++rr) USEG[((size_t)(task * 8 + w) * 32 + t * 4 + rr) * 64 + lane] = S[t][rr];
        if (tid < 128) GSEG[task * 128 + tid] = glog;
    }
}
__device__ void st_scan2(KP p, int bid, int nb) {
    const int tidx_ = ltid();
    const float* USEG = (const float*)(p->ws + RC_USEG); const float* GSEG = (const float*)(p->ws + RC_GSEG); float* SST = (float*)(p->ws + RC_SST);
    for (int i = bid * 512 + tidx_; i < 16 * 16384; i += nb * 512) {
        const int chain = i >> 14, idx = i & 16383, reg = (idx >> 6) & 31, ln = idx & 63, d = 16 * (reg >> 2) + 4 * (ln >> 4) + (reg & 3);
        float S = 0.f;
#pragma unroll
        for (int j = 0; j < 4; ++j) S = __expf(GSEG[(256 + chain * 4 + j) * 128 + d]) * S + USEG[(size_t)(256 + chain * 4 + j) * 16384 + idx];
        SST[(size_t)(chain * 16) * 16384 + idx] = S;
#pragma unroll 5
        for (int sg = 0; sg < 15; ++sg) {
            S = __expf(GSEG[(chain * 16 + sg) * 128 + d]) * S + USEG[(size_t)(chain * 16 + sg) * 16384 + idx];
            SST[(size_t)(chain * 16 + sg + 1) * 16384 + idx] = S;
        }
    }
}
constexpr int CR_RS = 132, CR_QRS = 272, CR_TILE = 2 * 64 * CR_QRS;
__device__ void st_corr_rec(KP p, PG8_LAS unsigned char* lds, int bid, int nb) {
    const int tidx_ = ltid();
    const float* SST = (const float*)(p->ws + RC_SST); const pg8::bf16_t* QT = (const pg8::bf16_t*)(p->ws + RC_PF);
    const pg8::bf16_t* PG = (const pg8::bf16_t*)(p->ws + RC_PG); const pg8::bf16_t* OF = (const pg8::bf16_t*)(p->ws + RC_OF); const pg8::bf16_t* OB = (const pg8::bf16_t*)(p->ws + RC_OB); pg8::bf16_t* MIX = (pg8::bf16_t*)(p->ws + RC_MIX);
    PG8_LAS float* tile = (PG8_LAS float*)(lds + CR_TILE);
    const int tid = tidx_, lane = tid & 63, w = tid >> 6, r = lane & 15, quad = lane >> 4;
    const int tk = tid >> 3, e0 = (tid & 7) * 16;
    const int qrow = tid >> 4, qseg = tid & 15;
    for (int item = bid; item < 256; item += nb) {
        const int half = item & 1, sg = (item >> 1) & 15, h = (item >> 5) & 3, b = item >> 7;
        const int rowi = b * L_ + 512 * sg + 256 * half;
        pg8::u32x4 qn[4], en[6];
#define CR_LOADS(c) do { const int row0_ = rowi + 64 * (c); \
            _Pragma("unroll") for (int k = 0; k < 4; ++k) qn[k] = *(const pg8::u32x4*)(QT + (size_t)(row0_ + qrow + 32 * (k & 1)) * 1024 + (k >> 1) * 512 + h * 128 + qseg * 8); \
            const size_t ro_ = (size_t)(row0_ + tk) * 512 + h * 128 + e0; \
            en[0] = *(const pg8::u32x4*)(OF + ro_); en[1] = *(const pg8::u32x4*)(OF + ro_ + 8); en[2] = *(const pg8::u32x4*)(OB + ro_); en[3] = *(const pg8::u32x4*)(OB + ro_ + 8); \
            en[4] = *(const pg8::u32x4*)(PG + ro_); en[5] = *(const pg8::u32x4*)(PG + ro_ + 8); } while (0)
        CR_LOADS(0);
        pg8::bf16x8 sb[2][4];
#pragma unroll
        for (int dir = 0; dir < 2; ++dir) {
            const int task = (dir * 8 + b * 4 + h) * 16 + (dir ? 15 - sg : sg);
            const float* Sp = SST + ((size_t)(task * 8 + w) * 32) * 64 + lane;
#pragma unroll
            for (int s2 = 0; s2 < 4; ++s2) {
                union { unsigned u[4]; pg8::bf16x8 v; } cv;
                cv.u[0] = pg8::cvt_pk_bf16(Sp[(8 * s2 + 0) * 64], Sp[(8 * s2 + 1) * 64]); cv.u[1] = pg8::cvt_pk_bf16(Sp[(8 * s2 + 2) * 64], Sp[(8 * s2 + 3) * 64]);
                cv.u[2] = pg8::cvt_pk_bf16(Sp[(8 * s2 + 4) * 64], Sp[(8 * s2 + 5) * 64]); cv.u[3] = pg8::cvt_pk_bf16(Sp[(8 * s2 + 6) * 64], Sp[(8 * s2 + 7) * 64]);
                sb[dir][s2] = cv.v;
            }
        }
        const pg8::f32x4 gr0 = *(const pg8::f32x4*)(p->g_rec + h * 128 + e0), gr1 = *(const pg8::f32x4*)(p->g_rec + h * 128 + e0 + 4), gr2 = *(const pg8::f32x4*)(p->g_rec + h * 128 + e0 + 8), gr3 = *(const pg8::f32x4*)(p->g_rec + h * 128 + e0 + 12);
        for (int c = 0; c < 4; ++c) {
            const int row0 = rowi + 64 * c;
#pragma unroll
            for (int k = 0; k < 4; ++k) *(PG8_LAS pg8::u32x4*)(lds + ((k >> 1) * 64 + qrow + 32 * (k & 1)) * CR_QRS + qseg * 16) = qn[k];
            const pg8::u32x4 f0 = en[0], f1 = en[1], b0 = en[2], b1 = en[3], g0 = en[4], g1 = en[5];
            __syncthreads();
            { const int cn = c + 1 < 4 ? c + 1 : c; CR_LOADS(cn); }
            pg8::f32x4 oacc[4];
#pragma unroll
            for (int it = 0; it < 4; ++it) oacc[it] = (pg8::f32x4){0.f, 0.f, 0.f, 0.f};
#pragma unroll
            for (int dir = 0; dir < 2; ++dir)
#pragma unroll
                for (int s2 = 0; s2 < 4; ++s2)
#pragma unroll
                    for (int it = 0; it < 4; ++it) {
                        const PG8_LAS unsigned char* qp = lds + (dir * 64 + 16 * it + r) * CR_QRS + (32 * s2 + 4 * quad) * 2;
                        union { u32x2_t hh[2]; pg8::bf16x8 v; } qa;
                        qa.hh[0] = *(const PG8_LAS u32x2_t*)qp; qa.hh[1] = *(const PG8_LAS u32x2_t*)(qp + 32);
                        oacc[it] = __builtin_amdgcn_mfma_f32_16x16x32_bf16(qa.v, sb[dir][s2], oacc[it], 0, 0, 0);
                    }
#pragma unroll
            for (int it = 0; it < 4; ++it)
#pragma unroll
                for (int rr = 0; rr < 4; ++rr) tile[(16 * it + 4 * quad + rr) * CR_RS + 16 * w + r] = oacc[it][rr];
            __syncthreads();
            float a[16];
#pragma unroll
            for (int q4 = 0; q4 < 4; ++q4) { const pg8::f32x4 t4 = *(const PG8_LAS pg8::f32x4*)(tile + tk * CR_RS + e0 + 4 * q4); a[4 * q4] = t4[0]; a[4 * q4 + 1] = t4[1]; a[4 * q4 + 2] = t4[2]; a[4 * q4 + 3] = t4[3]; }
            float gs[16];
#pragma unroll
            for (int j = 0; j < 4; ++j) {
                a[2 * j] += __uint_as_float(f0[j] << 16) + __uint_as_float(b0[j] << 16); a[2 * j + 1] += __uint_as_float(f0[j] & 0xffff0000u) + __uint_as_float(b0[j] & 0xffff0000u);
                a[8 + 2 * j] += __uint_as_float(f1[j] << 16) + __uint_as_float(b1[j] << 16); a[8 + 2 * j + 1] += __uint_as_float(f1[j] & 0xffff0000u) + __uint_as_float(b1[j] & 0xffff0000u);
                gs[2 * j] = __uint_as_float(g0[j] << 16); gs[2 * j + 1] = __uint_as_float(g0[j] & 0xffff0000u); gs[8 + 2 * j] = __uint_as_float(g1[j] << 16); gs[8 + 2 * j + 1] = __uint_as_float(g1[j] & 0xffff0000u);
            }
            float ss = 0.f;
#pragma unroll
            for (int j = 0; j < 16; ++j) ss += a[j] * a[j];
            ss += __shfl_xor(ss, 1); ss += __shfl_xor(ss, 2); ss += __shfl_xor(ss, 4);
            const float rstd = rsqrtf(ss * (1.0f / 128.0f) + EPS_);
            float y[16];
#pragma unroll
            for (int j = 0; j < 16; ++j) { const float wgt = (j < 4) ? gr0[j & 3] : (j < 8 ? gr1[j & 3] : (j < 12 ? gr2[j & 3] : gr3[j & 3])); y[j] = a[j] * rstd * wgt * siluf(gs[j]); }
            pg8::u32x4 o0, o1;
            o0.x = pg8::cvt_pk_bf16(y[0], y[1]); o0.y = pg8::cvt_pk_bf16(y[2], y[3]); o0.z = pg8::cvt_pk_bf16(y[4], y[5]); o0.w = pg8::cvt_pk_bf16(y[6], y[7]);
            o1.x = pg8::cvt_pk_bf16(y[8], y[9]); o1.y = pg8::cvt_pk_bf16(y[10], y[11]); o1.z = pg8::cvt_pk_bf16(y[12], y[13]); o1.w = pg8::cvt_pk_bf16(y[14], y[15]);
            pg8::bf16_t* mo = MIX + (size_t)(row0 + tk) * D_ + 512 + h * 128 + e0;
            *(pg8::u32x4*)mo = o0; *(pg8::u32x4*)(mo + 8) = o1;
        }
        __syncthreads();
#undef CR_LOADS
    }
}

__device__ void st_prep(KP p, PG8_LAS float* red, int bid, int nb) {
    const int tidx_ = ltid();
    float* MODP = (float*)(p->ws + WS_MODP); float* LB = (float*)(p->ws + WS_LB); float* CS = (float*)(p->ws + WS_COS);
    const int tid = tidx_, lane = tid & 63, wv = tid >> 6, gt = bid * 512 + tid, nt = nb * 512;
    for (int blk = bid; blk < 192; blk += nb) {
        const int cc = blk % 24, kg = blk / 24, k0 = kg * 128 + wv * 16;
        float4 wv4[16];
#pragma unroll
        for (int i = 0; i < 16; ++i) { const pg8::f32x4 t4 = __builtin_nontemporal_load((const pg8::f32x4*)(p->w_ada + (size_t)(k0 + i) * 6144 + cc * 256 + lane * 4)); wv4[i] = make_float4(t4[0], t4[1], t4[2], t4[3]); }
        float acc[3][4];
#pragma unroll
        for (int r = 0; r < 3; ++r)
#pragma unroll
            for (int q = 0; q < 4; ++q) acc[r][q] = 0.f;
#pragma unroll
        for (int i = 0; i < 16; ++i) {
            const float s0 = siluf(p->c[k0 + i]), s1 = siluf(p->c[D_ + k0 + i]), s2 = siluf(p->c_ctx[k0 + i]);
            acc[0][0] = fmaf(s0, wv4[i].x, acc[0][0]); acc[0][1] = fmaf(s0, wv4[i].y, acc[0][1]); acc[0][2] = fmaf(s0, wv4[i].z, acc[0][2]); acc[0][3] = fmaf(s0, wv4[i].w, acc[0][3]);
            acc[1][0] = fmaf(s1, wv4[i].x, acc[1][0]); acc[1][1] = fmaf(s1, wv4[i].y, acc[1][1]); acc[1][2] = fmaf(s1, wv4[i].z, acc[1][2]); acc[1][3] = fmaf(s1, wv4[i].w, acc[1][3]);
            acc[2][0] = fmaf(s2, wv4[i].x, acc[2][0]); acc[2][1] = fmaf(s2, wv4[i].y, acc[2][1]); acc[2][2] = fmaf(s2, wv4[i].z, acc[2][2]); acc[2][3] = fmaf(s2, wv4[i].w, acc[2][3]);
        }
        __syncthreads();
#pragma unroll
        for (int r = 0; r < 3; ++r) *(PG8_LAS pg8::f32x4*)(red + (wv * 3 + r) * 256 + lane * 4) = (pg8::f32x4){acc[r][0], acc[r][1], acc[r][2], acc[r][3]};
        __syncthreads();
        for (int e = tid; e < 768; e += 512) { float sm = 0.f;
#pragma unroll
            for (int w2 = 0; w2 < 8; ++w2) sm += red[w2 * 768 + e];
            MODP[(size_t)(kg * 3 + e / 256) * 6144 + cc * 256 + (e & 255)] = sm; }
    }
    for (int i = gt; i < 1024; i += nt) { const float l0 = p->lb_logits[i], l1 = p->lb_logits[1024 + i]; LB[i] = 1.0f / (1.0f + expf(l1 - l0)); }
    for (int i = gt; i < 8192; i += nt) CS[i] = cospif((float)i / 4096.0f);
}
__device__ void st_hcat(KP p, PG8_LAS float* tab, int bid, int nb) {
    const int tidx_ = ltid();
    const float* MODP = (const float*)(p->ws + WS_MODP); float* MOD = (float*)(p->ws + WS_MOD); pg8::bf16_t* H = (pg8::bf16_t*)(p->ws + RC_HCAT);
    const int tid = tidx_, lane = tid & 63, wv = tid >> 6;
    for (int i = bid * 512 + tid; i < 3 * 6144; i += nb * 512) { float sm = p->b_ada[i % 6144];
#pragma unroll
        for (int kg = 0; kg < 8; ++kg) sm += MODP[(size_t)kg * 18432 + i];
        MOD[i] = sm; }
    for (int grp = bid; grp < 256; grp += nb) {
        const int mr = grp >> 7, row0 = grp * 64;
        pg8::f32x4 v[4][4];
#define HCAT_LOAD(rb) do { _Pragma("unroll") for (int rr = 0; rr < 4; ++rr) { const float* src = p->x + (size_t)(row0 + wv * 8 + (rb) * 4 + rr) * D_; \
            _Pragma("unroll") for (int j = 0; j < 4; ++j) v[rr][j] = __builtin_nontemporal_load((const pg8::f32x4*)(src + j * 256 + lane * 4)); } } while (0)
        HCAT_LOAD(0);
        __syncthreads();
        for (int j = tid; j < 4096; j += 512) { const int jj = j & 2047, m2 = j < 2048 ? mr : 2; float sm = p->b_ada[jj];
#pragma unroll
            for (int kg = 0; kg < 8; ++kg) sm += MODP[(size_t)(kg * 3 + m2) * 6144 + jj];
            tab[j] = sm; }
        __syncthreads();
#pragma unroll
        for (int rb = 0; rb < 2; ++rb) {
            float rstd[4];
#pragma unroll
            for (int rr = 0; rr < 4; ++rr) { float ss = 0.f;
#pragma unroll
                for (int j = 0; j < 4; ++j) ss += v[rr][j][0] * v[rr][j][0] + v[rr][j][1] * v[rr][j][1] + v[rr][j][2] * v[rr][j][2] + v[rr][j][3] * v[rr][j][3];
                rstd[rr] = rsqrtf(wave_sum(ss) * (1.0f / D_) + EPS_); }
#pragma unroll
            for (int j = 0; j < 4; ++j) {
                const int col = j * 256 + lane * 4; const pg8::f32x4 g = *(const pg8::f32x4*)(p->g_mix + col), sh = *(const PG8_LAS pg8::f32x4*)(tab + col), sc = *(const PG8_LAS pg8::f32x4*)(tab + 1024 + col);
                const pg8::f32x4 gs = g * (sc + 1.0f);
#pragma unroll
                for (int rr = 0; rr < 4; ++rr) { const int row = row0 + wv * 8 + rb * 4 + rr; const pg8::f32x4 o = v[rr][j] * rstd[rr] * gs + sh;
                    u32x2_t w; w.x = pg8::cvt_pk_bf16(o[0], o[1]); w.y = pg8::cvt_pk_bf16(o[2], o[3]); *(u32x2_t*)(H + (size_t)row * D_ + col) = w; }
            }
            if (rb == 0) HCAT_LOAD(1);
        }
#undef HCAT_LOAD
        if (wv < 2) {
            const int crow = 2 * grp + wv; const float* src = p->ctx + (size_t)crow * D_; pg8::f32x4 c4[4]; float ss = 0.f;
#pragma unroll
            for (int j = 0; j < 4; ++j) { c4[j] = *(const pg8::f32x4*)(src + j * 256 + lane * 4); ss += c4[j][0] * c4[j][0] + c4[j][1] * c4[j][1] + c4[j][2] * c4[j][2] + c4[j][3] * c4[j][3]; }
            const float rs = rsqrtf(wave_sum(ss) * (1.0f / D_) + EPS_);
#pragma unroll
            for (int j = 0; j < 4; ++j) { const int col = j * 256 + lane * 4; const pg8::f32x4 g = *(const pg8::f32x4*)(p->g_mix + col), sh = *(const PG8_LAS pg8::f32x4*)(tab + 2048 + col), sc = *(const PG8_LAS pg8::f32x4*)(tab + 3072 + col);
                const pg8::f32x4 o = c4[j] * rs * (g * (sc + 1.0f)) + sh; u32x2_t w; w.x = pg8::cvt_pk_bf16(o[0], o[1]); w.y = pg8::cvt_pk_bf16(o[2], o[3]); *(u32x2_t*)(H + (size_t)(RL_ + crow) * D_ + col) = w; }
        }
    }
}
__device__ __forceinline__ float bfly_reduce16(float (&lg)[16], int lane) {
#pragma unroll
    for (int i = 0; i < 8; ++i) { const bool hi = lane & 32; const float snd = hi ? lg[i] : lg[i + 8], kp = hi ? lg[i + 8] : lg[i]; lg[i] = kp + __shfl_xor(snd, 32); }
#pragma unroll
    for (int i = 0; i < 4; ++i) { const bool hi = lane & 16; const float snd = hi ? lg[i] : lg[i + 4], kp = hi ? lg[i + 4] : lg[i]; lg[i] = kp + __shfl_xor(snd, 16); }
#pragma unroll
    for (int i = 0; i < 2; ++i) { const bool hi = lane & 8; const float snd = hi ? lg[i] : lg[i + 2], kp = hi ? lg[i + 2] : lg[i]; lg[i] = kp + __shfl_xor(snd, 8); }
    { const bool hi = lane & 4; const float snd = hi ? lg[0] : lg[1], kp = hi ? lg[1] : lg[0]; lg[0] = kp + __shfl_xor(snd, 4); }
    float v = lg[0]; v += __shfl_xor(v, 2); v += __shfl_xor(v, 1);
    return v;
}
__device__ void st_router(KP p, PG8_LAS float* wl, int bid, int nb) {
    const int tidx_ = ltid();
    const float* MOD = (const float*)(p->ws + WS_MOD); const _Float16* X1 = (const _Float16*)(p->ws + RC_X1); unsigned char* H2B = p->ws + RC_H2B; float* AFF = (float*)(p->ws + WS_AFF);
    const int lane = tidx_ & 63, wv = tidx_ >> 6;
    __syncthreads();
    for (int i = tidx_; i < 16384; i += 512) wl[(i & 15) * 1028 + (i >> 4)] = p->w_router[i];
    __syncthreads();
    const int eidx = ((lane >> 5) & 1) * 8 + ((lane >> 4) & 1) * 4 + ((lane >> 3) & 1) * 2 + ((lane >> 2) & 1);
    for (int grp = bid; grp < RL_ / 64; grp += nb) {
        const int bb = grp >> 7; const float* md = MOD + bb * 6144;
#pragma unroll 1
        for (int pr = 0; pr < 4; ++pr) {
            const int rowA = grp * 64 + wv * 8 + pr * 2, rowB = rowA + 1;
            pg8::f32x4 xa[4], xb[4]; float sa = 0.f, sb = 0.f;
#pragma unroll
            for (int j = 0; j < 4; ++j) { const h4v_t ha4 = *(const h4v_t*)(X1 + (size_t)rowA * D_ + j * 256 + lane * 4), hb4 = *(const h4v_t*)(X1 + (size_t)rowB * D_ + j * 256 + lane * 4);
                xa[j] = (pg8::f32x4){(float)ha4[0], (float)ha4[1], (float)ha4[2], (float)ha4[3]}; xb[j] = (pg8::f32x4){(float)hb4[0], (float)hb4[1], (float)hb4[2], (float)hb4[3]}; }
#pragma unroll
            for (int j = 0; j < 4; ++j) { sa += xa[j][0] * xa[j][0] + xa[j][1] * xa[j][1] + xa[j][2] * xa[j][2] + xa[j][3] * xa[j][3]; sb += xb[j][0] * xb[j][0] + xb[j][1] * xb[j][1] + xb[j][2] * xb[j][2] + xb[j][3] * xb[j][3]; }
            sa = wave_sum(sa); sb = wave_sum(sb);
            const float ra = rsqrtf(sa * (1.0f / D_) + EPS_), rb = rsqrtf(sb * (1.0f / D_) + EPS_);
            float la[16], lb[16];
#pragma unroll
            for (int e = 0; e < 16; ++e) { la[e] = 0.f; lb[e] = 0.f; }
#pragma unroll
            for (int j = 0; j < 4; ++j) {
                const int col = j * 256 + lane * 4; const pg8::f32x4 g = *(const pg8::f32x4*)(p->g_ffn + col), sh = *(const pg8::f32x4*)(md + 3072 + col), sc = *(const pg8::f32x4*)(md + 4096 + col);
                const pg8::f32x4 gs = g * (sc + 1.0f); const pg8::f32x4 ha = xa[j] * ra * gs + sh, hb = xb[j] * rb * gs + sh;
                *(unsigned*)(H2B + (size_t)rowA * D_ + col) = pk4_fp8(__builtin_amdgcn_fmed3f(ha[0] * 4.0f, -448.f, 448.f), __builtin_amdgcn_fmed3f(ha[1] * 4.0f, -448.f, 448.f), __builtin_amdgcn_fmed3f(ha[2] * 4.0f, -448.f, 448.f), __builtin_amdgcn_fmed3f(ha[3] * 4.0f, -448.f, 448.f));
                *(unsigned*)(H2B + (size_t)rowB * D_ + col) = pk4_fp8(__builtin_amdgcn_fmed3f(hb[0] * 4.0f, -448.f, 448.f), __builtin_amdgcn_fmed3f(hb[1] * 4.0f, -448.f, 448.f), __builtin_amdgcn_fmed3f(hb[2] * 4.0f, -448.f, 448.f), __builtin_amdgcn_fmed3f(hb[3] * 4.0f, -448.f, 448.f));
#pragma unroll
                for (int e = 0; e < 16; ++e) { const pg8::f32x4 w4 = *(const PG8_LAS pg8::f32x4*)(wl + e * 1028 + col);
                    la[e] += ha[0] * w4[0] + ha[1] * w4[1] + ha[2] * w4[2] + ha[3] * w4[3]; lb[e] += hb[0] * w4[0] + hb[1] * w4[1] + hb[2] * w4[2] + hb[3] * w4[3];
                    if ((e & 3) == 3) asm volatile("" ::: "memory"); }
            }
            float va = bfly_reduce16(la, lane), vb = bfly_reduce16(lb, lane);
            float ma = va, mb = vb;
#pragma unroll
            for (int o = 4; o < 64; o <<= 1) { ma = fmaxf(ma, __shfl_xor(ma, o)); mb = fmaxf(mb, __shfl_xor(mb, o)); }
            va = expf(va - ma); vb = expf(vb - mb); float ta = va, tb = vb;
#pragma unroll
            for (int o = 4; o < 64; o <<= 1) { ta += __shfl_xor(ta, o); tb += __shfl_xor(tb, o); }
            if ((lane & 3) == 0) { AFF[(size_t)(bb * 16 + eidx) * L_ + (rowA & 8191)] = va / ta; AFF[(size_t)(bb * 16 + eidx) * L_ + (rowB & 8191)] = vb / tb; }
        }
    }
}
__device__ void st_topk(KP p, PG8_LAS int* sh, int bid, int nb) {
    const int tidx_ = ltid();
    const float* AFF = (const float*)(p->ws + WS_AFF); int* IDX = (int*)(p->ws + WS_IDX); float* GATE = (float*)(p->ws + WS_GATE); int* SLOT = (int*)(p->ws + WS_SLOT); float* GATER = (float*)(p->ws + WS_GATER);
    const int tid = tidx_, lane = tid & 63, wv = tid >> 6;
    for (int it = bid; it < 32; it += nb) {
        const int bb = it >> 4, e = it & 15;
        unsigned key[16];
        { const uint4* src = (const uint4*)(AFF + (size_t)(bb * 16 + e) * L_ + tid * 16);
#pragma unroll
          for (int q = 0; q < 4; ++q) { const uint4 v = src[q]; key[4 * q] = v.x; key[4 * q + 1] = v.y; key[4 * q + 2] = v.z; key[4 * q + 3] = v.w; } }
        unsigned prefix = 0u, mask = 0u; int need = CAP_;
        for (int pass = 0; pass < 4; ++pass) {
            const int shift = 24 - 8 * pass;
            __syncthreads();
            if (tid < 256) sh[tid] = 0;
            __syncthreads();
#pragma unroll
            for (int i = 0; i < 16; ++i) if ((key[i] & mask) == prefix) __hip_atomic_fetch_add(sh + ((key[i] >> shift) & 255), 1, __ATOMIC_RELAXED, __HIP_MEMORY_SCOPE_WORKGROUP);
            __syncthreads();
            if (wv == 0) {
                int h4[4]; int tot = 0;
#pragma unroll
                for (int q = 0; q < 4; ++q) { h4[q] = sh[4 * lane + q]; tot += h4[q]; }
                int incl = tot;
#pragma unroll
                for (int o = 1; o < 64; o <<= 1) { const int v = __shfl_down(incl, o); if (lane + o < 64) incl += v; }
                int above = incl - tot;
#pragma unroll
                for (int q = 3; q >= 0; --q) { if (above < need && above + h4[q] >= need) { sh[256] = 4 * lane + q; sh[257] = need - above; } above += h4[q]; }
            }
            __syncthreads();
            prefix |= (unsigned)sh[256] << shift; mask |= 255u << shift; need = sh[257];
        }
        int cg = 0, ce = 0;
#pragma unroll
        for (int i = 0; i < 16; ++i) { cg += key[i] > prefix; ce += key[i] == prefix; }
        int v = cg | (ce << 16), incl = v;
#pragma unroll
        for (int o = 1; o < 64; o <<= 1) { const int u = __shfl_up(incl, o); if (lane >= o) incl += u; }
        __syncthreads();
        if (lane == 63) sh[260 + wv] = incl;
        __syncthreads();
        int base = 0;
#pragma unroll
        for (int w2 = 0; w2 < 8; ++w2) if (w2 < wv) base += sh[260 + w2];
        const int excl = base + incl - v; int ng = excl & 0xffff, ne = excl >> 16;
#pragma unroll
        for (int i = 0; i < 16; ++i) {
            const int t = tid * 16 + i; const bool g = key[i] > prefix, q = key[i] == prefix, take = g || (q && ne < need);
            const int slot = ng + (ne < need ? ne : need);
            if (take) { const float a = __uint_as_float(key[i]); IDX[(bb * 16 + e) * 1024 + slot] = t; GATE[(bb * 16 + e) * 1024 + slot] = a; GATER[e * 2048 + bb * 1024 + slot] = a; }
            SLOT[(size_t)(bb * L_ + t) * 16 + e] = take ? slot : -1;
            ng += g; ne += q;
        }
    }
}
__device__ void st_final(KP p, int bid, int nb) {
    const int tidx_ = ltid();
    const float* MOD = (const float*)(p->ws + WS_MOD); const _Float16* X1 = (const _Float16*)(p->ws + RC_X1); const pg8::bf16_t* YE = (const pg8::bf16_t*)(p->ws + WS_YE); const int* SLOT = (const int*)(p->ws + WS_SLOT);
    const int lane = tidx_ & 63, gw = bid * 8 + (tidx_ >> 6), nw = nb * 8;
    for (int row0 = gw * 2; row0 < RL_; row0 += nw * 2) {
        const int bb = row0 >> 13; const float* md = MOD + bb * 6144;
        const int sl = SLOT[(size_t)row0 * 16 + (lane & 31)];
        pg8::f32x4 xv[2][4];
#pragma unroll
        for (int r = 0; r < 2; ++r)
#pragma unroll
            for (int jh = 0; jh < 2; ++jh) { const h8v_t h8 = *(const h8v_t*)(X1 + (size_t)(row0 + r) * D_ + jh * 512 + lane * 8);
                xv[r][2 * jh] = (pg8::f32x4){(float)h8[0], (float)h8[1], (float)h8[2], (float)h8[3]}; xv[r][2 * jh + 1] = (pg8::f32x4){(float)h8[4], (float)h8[5], (float)h8[6], (float)h8[7]}; }
        const unsigned long long bal = __ballot(sl >= 0);
        pg8::f32x4 acc[2][4];
#pragma unroll
        for (int r = 0; r < 2; ++r) {
#pragma unroll
            for (int j = 0; j < 4; ++j) acc[r][j] = (pg8::f32x4){0.f, 0.f, 0.f, 0.f};
            unsigned m = (unsigned)(bal >> (16 * r)) & 0xffffu;
            while (m) {
                const int e = __builtin_ctz(m); m &= m - 1;
                const int c = __builtin_amdgcn_readlane(sl, 16 * r + e);
                const pg8::bf16_t* yr = YE + (size_t)(e * 2048 + bb * 1024 + c) * D_ + lane * 8;
#pragma unroll
                for (int jh = 0; jh < 2; ++jh) { const pg8::u32x4 y = *(const pg8::u32x4*)(yr + jh * 512);
                    acc[r][2 * jh][0] += __uint_as_float(y.x << 16); acc[r][2 * jh][1] += __uint_as_float(y.x & 0xffff0000u); acc[r][2 * jh][2] += __uint_as_float(y.y << 16); acc[r][2 * jh][3] += __uint_as_float(y.y & 0xffff0000u);
                    acc[r][2 * jh + 1][0] += __uint_as_float(y.z << 16); acc[r][2 * jh + 1][1] += __uint_as_float(y.z & 0xffff0000u); acc[r][2 * jh + 1][2] += __uint_as_float(y.w << 16); acc[r][2 * jh + 1][3] += __uint_as_float(y.w & 0xffff0000u); }
            }
        }
#pragma unroll
        for (int r = 0; r < 2; ++r) {
            pg8::f32x4 v[4]; float ss = 0.f;
#pragma unroll
            for (int j = 0; j < 4; ++j) { const pg8::f32x4 gt = *(const pg8::f32x4*)(md + 5120 + (j >> 1) * 512 + lane * 8 + (j & 1) * 4); v[j] = xv[r][j] + gt * acc[r][j]; ss += v[j][0] * v[j][0] + v[j][1] * v[j][1] + v[j][2] * v[j][2] + v[j][3] * v[j][3]; }
            ss = wave_sum(ss); const float rstd = rsqrtf(ss * (1.0f / D_) + EPS_);
#pragma unroll
            for (int j = 0; j < 4; ++j) { const int col = (j >> 1) * 512 + lane * 8 + (j & 1) * 4; const pg8::f32x4 g = *(const pg8::f32x4*)(p->g_final + col); *(pg8::f32x4*)(p->out + (size_t)(row0 + r) * D_ + col) = v[j] * rstd * g; }
        }
    }
}

#define XB_TMO      128
#define XB_XCNT(j)  (256  + 64 * (j))
#define XB_XSUB(j)  (1280 + 64 * (j))
#define XB_XGEN(j)  (2304 + 64 * (j))
#define XB_TOP      3328
#define XB_TOPGEN   3392
#define XCD_BAR_WORDS 3456
#define XB_SPIN_CAP (1u << 20)
__device__ __forceinline__ unsigned xb_ld(unsigned* q)              { return __hip_atomic_load(q, __ATOMIC_RELAXED, __HIP_MEMORY_SCOPE_AGENT); }
__device__ __forceinline__ unsigned xb_add(unsigned* q, unsigned v) { return __hip_atomic_fetch_add(q, v, __ATOMIC_RELAXED, __HIP_MEMORY_SCOPE_AGENT); }
__device__ __forceinline__ unsigned xb_xcc_id() { return (unsigned)__builtin_amdgcn_s_getreg((3 << 11) | 20) & 0xFu; }
#define XB_SPIN(cond, bar) do { unsigned _sp = 0; while (cond) { __builtin_amdgcn_s_sleep(1); \
    if ((++_sp & 255u) == 0u) { if (xb_ld(&(bar)[XB_TMO])) break; if (_sp > XB_SPIN_CAP) { atomicAdd(&(bar)[XB_TMO], 1u); break; } } } } while (0)
struct XcdBarrier { unsigned* bar; unsigned x; volatile PG8_LAS unsigned* st; };
__device__ __forceinline__ XcdBarrier xcd_barrier_post(unsigned* bar, volatile PG8_LAS unsigned* st) {
    XcdBarrier b; b.bar = bar; b.x = xb_xcc_id(); b.st = st;
    if (threadIdx.x == 0) (void)xb_add(&bar[XB_XCNT(b.x)], 1u);
    return b;
}
__device__ __forceinline__ void xcd_barrier_complete(unsigned* bar, unsigned x, unsigned& nloc, unsigned& nx) {
    const unsigned G = gridDim.x * gridDim.y * gridDim.z;
    unsigned sum, cnt, mine, sp = 0u;
    for (;;) {
        sum = 0u; cnt = 0u; mine = 0u;
#pragma unroll
        for (unsigned j = 0; j < 16; ++j) { const unsigned c = xb_ld(&bar[XB_XCNT(j)]); sum += c; cnt += (c > 0u) ? 1u : 0u; mine = (j == x) ? c : mine; }
        if (sum == G) break;
        __builtin_amdgcn_s_sleep(1);
        if ((++sp & 255u) == 0u) { if (xb_ld(&bar[XB_TMO])) break; if (sp > XB_SPIN_CAP) { atomicAdd(&bar[XB_TMO], 1u); break; } }
    }
    nloc = mine > 0u ? mine : 1u; nx = cnt > 0u ? cnt : 1u;
}
__device__ __forceinline__ void xcd_barrier(const XcdBarrier& b) {
    asm volatile("s_waitcnt vmcnt(0)" ::: "memory");
    __syncthreads();
    if (threadIdx.x == 0) {
        unsigned* bar = b.bar;
        __builtin_amdgcn_s_waitcnt(0);
        unsigned nloc = b.st[0], nx = b.st[1];
        if (nloc == 0u) { xcd_barrier_complete(bar, b.x, nloc, nx); b.st[0] = nloc; b.st[1] = nx; }
        const unsigned old = xb_add(&bar[XB_XSUB(b.x)], 1u);
        const unsigned gen = old / nloc;
        if (old + 1u == (gen + 1u) * nloc) {
            __builtin_amdgcn_fence(__ATOMIC_RELEASE, "agent");
            asm volatile("s_waitcnt vmcnt(0)" ::: "memory");
            const unsigned og = xb_add(&bar[XB_TOP], 1u);
            const unsigned tg = og / nx;
            if (og + 1u == (tg + 1u) * nx) xb_add(&bar[XB_TOPGEN], 1u);
            else XB_SPIN(xb_ld(&bar[XB_TOPGEN]) == tg, bar);
            __builtin_amdgcn_fence(__ATOMIC_ACQUIRE, "agent");
            xb_add(&bar[XB_XGEN(b.x)], 1u);
            asm volatile("s_waitcnt vmcnt(0)" ::: "memory");
        } else {
            XB_SPIN(xb_ld(&bar[XB_XGEN(b.x)]) == gen, bar);
            __builtin_amdgcn_fence(__ATOMIC_ACQUIRE, "agent");
            asm volatile("s_waitcnt vmcnt(0)" ::: "memory");
        }
    }
    __syncthreads();
}

constexpr int GOFS_OFF = 131072 + 16, GOFS_UNITS = 24;
constexpr int LDS_BYTES = GOFS_OFF + GOFS_UNITS * 1024;
__global__ void __launch_bounds__(512, 2) mega(Params p) {
    cg::grid_group grid = cg::this_grid();
    extern __shared__ __attribute__((aligned(16))) unsigned char smem[];
    float* lds = (float*)smem;
    const int bid = blockIdx.x, nb = gridDim.x;
    unsigned char* ws = p.ws;
    if (threadIdx.x == 0) { *(volatile PG8_LAS unsigned*)((PG8_LAS unsigned char*)smem + 131072) = 0u; *(volatile PG8_LAS unsigned*)((PG8_LAS unsigned char*)smem + 131076) = 0u; }
    __syncthreads();
    const XcdBarrier xbar = xcd_barrier_post((unsigned*)(ws + WS_BAR), (volatile PG8_LAS unsigned*)((PG8_LAS unsigned char*)smem + 131072));
#ifndef PROBE_MASK
#define PROBE_MASK 0
#endif
#define PH(k) for (int rep_ = 0; rep_ < (((PROBE_MASK) >> (k)) & 1 ? 4 : 1); ++rep_)
    PH(0) { const KP q = kargs();  st_prep(q, (PG8_LAS float*)smem, bid, nb);
    st_dft_consts(q, (PG8_LAS float*)smem, bid, nb);
    st_convert_dense(q, (PG8_LAS unsigned*)smem, bid, nb); }
    if (p.ws == nullptr) grid.sync();
    xcd_barrier(xbar);
    PH(1) { const KP q = kargs();  st_hcat(q, (PG8_LAS float*)smem, bid, nb); }
    xcd_barrier(xbar);
    PH(2) { const KP q = kargs();
      const int NG = nb >= 64 ? (nb * 33 / 64) : nb;
      if (bid < NG) { pg8::Gemm g{(const pg8::bf16_t*)(q->ws + RC_HCAT), (const pg8::bf16_t*)(q->ws + WS_WINT), D_}; SchedDense S; S.init(RT_, DIN_, NG, bid); EpiWin E{q->ws, (const float*)(q->ws + WS_LB)};
        pg8::gemm_phase((PG8_LAS unsigned char*)smem, g, S, E); }
      if (bid >= NG || NG == nb) st_convert_moe(q, (PG8_LAS unsigned*)smem, NG == nb ? bid : bid - NG, NG == nb ? nb : nb - NG); }
    xcd_barrier(xbar);
    PH(3) { const KP q = kargs();  st_scan1(q, (PG8_LAS unsigned char*)smem, bid, nb);
    st_dft0(q, (PG8_LAS unsigned char*)smem, bid, nb); }
    xcd_barrier(xbar);
    PH(4) { const KP q = kargs();  st_scan2(q, bid, nb);
    st_dftA(q, (PG8_LAS unsigned char*)smem, bid, nb); }
    xcd_barrier(xbar);
    PH(5) { const KP q = kargs();  st_dftC(q, bid, nb);
    st_corr_rec(q, (PG8_LAS unsigned char*)smem, bid, nb); }
    xcd_barrier(xbar);
    PH(7) { const KP q = kargs();  pg8::Gemm g{(const pg8::bf16_t*)(q->ws + RC_MIX), (const pg8::bf16_t*)(q->ws + WS_WOUTT), D_}; SchedDense S; S.init(RL_, D_, nb, bid); EpiWout E{(_Float16*)(q->ws + RC_X1), q->x, (const float*)(q->ws + WS_MOD)};
      pg8::gemm_phase((PG8_LAS unsigned char*)smem, g, S, E); }
    xcd_barrier(xbar);
    PH(8) { const KP q = kargs();  st_router(q, (PG8_LAS float*)smem, bid, nb); }
    xcd_barrier(xbar);
    PH(9) { const KP q = kargs();  st_topk(q, (PG8_LAS int*)smem, bid, nb); }
    xcd_barrier(xbar);
    const bool fuse_gather = (2816 + nb - 1) / nb <= GOFS_UNITS;
    if (!fuse_gather) { PH(10) { const KP q = kargs();  st_gather(q, bid, nb); }
    xcd_barrier(xbar); }
    PH(11) { const KP q = kargs();
      SchedGU S{nb, bid};
      if (fuse_gather) {
        PG8_LAS unsigned* gofs = (PG8_LAS unsigned*)((PG8_LAS unsigned char*)smem + GOFS_OFF);
        { const int* IDX = (const int*)(q->ws + WS_IDX); pg8::Unit u; const int t_ = ltid();
          for (int i = 0; S.next(i, u); ++i) if (t_ < 256) { const int row = u.pm * 256 + t_, e = row >> 11, bb = (row >> 10) & 1, c = row & 1023;
              gofs[i * 256 + t_] = (unsigned)(bb * L_ + IDX[(bb * 16 + e) * 1024 + c]) * (unsigned)D_; }
          __syncthreads(); }
        pg8::Gemm g{(const pg8::bf16_t*)(q->ws + RC_H2B), (const pg8::bf16_t*)(q->ws + WS_WGU), D_ / 2}; EpiGU E{q->ws + RC_HID};
        pg8::gemm_phase<EpiGU, SchedGU, true, 0x79 | (0x7d << 8)>((PG8_LAS unsigned char*)smem, g, S, E, gofs);
      } else {
        pg8::Gemm g{(const pg8::bf16_t*)(q->ws + RC_XS), (const pg8::bf16_t*)(q->ws + WS_WGU), D_ / 2}; EpiGU E{q->ws + RC_HID};
        pg8::gemm_phase<EpiGU, SchedGU, false, 0x79 | (0x7d << 8)>((PG8_LAS unsigned char*)smem, g, S, E);
      } }
    xcd_barrier(xbar);
    PH(12) { const KP q = kargs();  pg8::Gemm g{(const pg8::bf16_t*)(q->ws + RC_HID), (const pg8::bf16_t*)(q->ws + WS_WD), DE_ / 2}; SchedDown S{nb, bid}; EpiDown E{(pg8::bf16_t*)(q->ws + WS_YE), (const float*)(q->ws + WS_GATER)};
      pg8::gemm_phase<EpiDown, SchedDown, false, 0x79 | (0x7c << 8)>((PG8_LAS unsigned char*)smem, g, S, E); }
    xcd_barrier(xbar);
    PH(13) { const KP q = kargs();  st_final(q, bid, nb); }
}

extern "C" void kernel_launch(void* const* d_in, const int* in_sizes, int n_in, void* d_out, int out_size, void* d_ws, size_t ws_size, hipStream_t stream) {
    static int grid_blocks = 0;
    if (!grid_blocks) {
        int dev = 0, cus = 0, per_cu = 0;
        (void)hipGetDevice(&dev);
        (void)hipDeviceGetAttribute(&cus, hipDeviceAttributeMultiprocessorCount, dev);
        if (hipFuncSetAttribute((const void*)mega, hipFuncAttributeMaxDynamicSharedMemorySize, LDS_BYTES) != hipSuccess) fprintf(stderr, "hipFuncSetAttribute failed\n");
        (void)hipOccupancyMaxActiveBlocksPerMultiprocessor(&per_cu, mega, 512, LDS_BYTES);
        if (per_cu < 1) per_cu = 1;
        grid_blocks = cus * per_cu;
        if (ws_size < WS_END) { fprintf(stderr, "workspace too small: %zu < %zu\n", ws_size, (size_t)WS_END); grid_blocks = -1; }
    }
    if (grid_blocks < 0) return;
    Params p{};
    const float** pp = (const float**)&p;
    for (int i = 0; i < 18; ++i) pp[i] = (const float*)d_in[i];
    p.out = (float*)d_out; p.ws = (unsigned char*)d_ws;
    (void)hipMemsetAsync((unsigned char*)d_ws + WS_BAR, 0, XCD_BAR_WORDS * 4, stream);
    void* args[] = {&p};
    hipError_t e = hipLaunchCooperativeKernel((void*)mega, dim3(grid_blocks), dim3(512), args, LDS_BYTES, stream);
    if (e != hipSuccess) fprintf(stderr, "cooperative launch failed: %s (grid %d)\n", hipGetErrorString(e), grid_blocks);
}
```

```cpp
#include <hip/hip_runtime.h>
#include <hip/hip_cooperative_groups.h>
#include <cstdio>
namespace cg = cooperative_groups;

constexpr int NB_ = 2, L_ = 8192, D_ = 1024, CTX_ = 256, DIN_ = 3072, NE_ = 16, CAP_ = 1024, DE_ = 2816;
constexpr int RL_ = NB_ * L_, RC_ = NB_ * CTX_, RT_ = RL_ + RC_;
constexpr float EPS_ = 1e-6f;

constexpr size_t WS_MOD = 0;
constexpr size_t WS_LB = WS_MOD + 3 * 6144 * 4;
constexpr size_t WS_COS = WS_LB + 2 * 512 * 4;
constexpr size_t WS_AFF = WS_COS + 8192 * 4;
constexpr size_t WS_IDX = WS_AFF + (size_t)RL_ * 16 * 4;
constexpr size_t WS_GATE = WS_IDX + 2 * 16 * 1024 * 4;
constexpr size_t WS_SLOT = WS_GATE + 2 * 16 * 1024 * 4;
constexpr size_t WS_GATER = WS_SLOT + (size_t)RL_ * 16 * 4;
constexpr size_t WS_WINT = (WS_GATER + 32768 * 4 + 4095) / 4096 * 4096;
constexpr size_t WS_WOUTT = WS_WINT + (size_t)DIN_ * D_ * 2;
constexpr size_t WS_PU = WS_WOUTT + (size_t)D_ * D_ * 2;
constexpr size_t WS_W12T = WS_PU + (size_t)RL_ * 512 * 2;
constexpr size_t WS_FA = WS_W12T + 4 * 256 * 128 * 2;
constexpr size_t WS_FC = WS_FA + 256 * 256 * 2;
constexpr size_t WS_MODP = WS_FC + 64 * 128 * 2;
constexpr size_t WS_BAR = WS_MODP + 8 * 3 * 6144 * 4;
constexpr size_t WS_WGU = (WS_BAR + 16384 + 4095) / 4096 * 4096;
constexpr size_t WS_WD = WS_WGU + (size_t)16 * 22 * 256 * 1024;
constexpr size_t WS_YE = WS_WGU;
constexpr size_t WS_RC = WS_WD + (size_t)16 * 1024 * 2816;
constexpr size_t RC_HCAT = WS_RC;
constexpr size_t RC_PQ = RC_HCAT + (size_t)RT_ * D_ * 2;
constexpr size_t RC_PV = RC_PQ + (size_t)RT_ * 512 * 2;
constexpr size_t RC_PG = RC_PV + (size_t)RT_ * 512 * 2;
constexpr size_t RC_PF = RC_PG + (size_t)RT_ * 512 * 2;
constexpr size_t RC_XF = RC_PF + (size_t)RT_ * 1024 * 2;
constexpr size_t RC_YF = RC_XF + (size_t)RL_ * 512 * 2 * 2;
constexpr size_t RC_USEG = RC_YF + (size_t)RL_ * 512 * 2 * 2;
constexpr size_t RC_SST = RC_USEG + (size_t)320 * 16384 * 4;
constexpr size_t RC_GSEG = RC_SST + (size_t)256 * 16384 * 4;
constexpr size_t RC_OF = RC_GSEG + 320 * 128 * 4;
constexpr size_t RC_OB = RC_OF + (size_t)RL_ * 512 * 2;
constexpr size_t RC_MIX = RC_OB + (size_t)RL_ * 512 * 2;
constexpr size_t RC_END1 = RC_MIX + (size_t)RL_ * D_ * 2;
constexpr size_t RC_X1 = WS_RC;
constexpr size_t RC_H2B = RC_PG;
constexpr size_t RC_XS = RC_H2B + (size_t)RL_ * D_;
constexpr size_t RC_HID = RC_XS + (size_t)32768 * D_;
constexpr size_t RC_END2 = RC_HID + (size_t)32768 * DE_;
constexpr size_t WS_END = RC_END1 > RC_END2 ? RC_END1 : RC_END2;
static_assert(RC_X1 + (size_t)RL_ * D_ * 2 <= RC_PG, "X1 overlay");
static_assert(WS_END <= (size_t)4 * 16 * 1024 * 2816 * 4, "workspace budget (4 x largest input)");

struct Params {
    const float *x, *c, *ctx, *c_ctx, *w_ada, *b_ada, *g_mix, *w_in, *w_f, *lb_logits, *g_rec, *w_out, *g_ffn, *w_router, *w_g, *w_u, *w_d, *g_final;
    float* out;
    unsigned char* ws;
};

typedef const __attribute__((address_space(4))) Params* KP;
__device__ __forceinline__ KP kargs() { KP k = (KP)__builtin_amdgcn_kernarg_segment_ptr(); asm volatile("" : "+s"(k)); return k; }
__device__ __forceinline__ int ltid() { int t = threadIdx.x; asm volatile("" : "+v"(t)); return t; }
__device__ __forceinline__ float siluf(float v) { return v * __builtin_amdgcn_rcpf(1.0f + __expf(-v)); }
__device__ __forceinline__ float sigmf(float v) { return __builtin_amdgcn_rcpf(1.0f + __expf(-v)); }
__device__ __forceinline__ float wave_sum(float v) {
#pragma unroll
    for (int o = 32; o >= 1; o >>= 1) v += __shfl_xor(v, o);
    return v;
}

namespace pg8 {
#define PG8_LAS __attribute__((address_space(3)))
typedef unsigned short bf16_t;
typedef short bf16x8 __attribute__((ext_vector_type(8)));
typedef float f32x4 __attribute__((ext_vector_type(4)));
typedef unsigned u32x4 __attribute__((ext_vector_type(4)));
constexpr int BM = 256, BK = 64, HALF = 128, HTB = HALF * BK * 2, STAGE_BYTES = 8 * HTB;
__device__ __forceinline__ int lds_byte(int r, int c) { const int st = (r >> 4) * 2 + (c >> 5), rr = r & 15, cc = c & 31, ob = rr * 64 + cc * 2; return st * 1024 + (ob ^ (((ob >> 9) & 1) << 5)); }
__device__ __forceinline__ void stage_rc(int b, int& R, int& C) { const int st = b / 1024, sb = b % 1024, swz = sb ^ (((sb >> 9) & 1) << 5); R = (st >> 1) * 16 + swz / 64; C = (st & 1) * 32 + (swz % 64) / 2; }
__device__ __forceinline__ int perm32(int rho) { const int n = rho >> 4, i = rho & 15; return 8 * (i >> 2) + 4 * n + (i & 3); }
struct Unit { int pm, pn; };
struct Gemm { const bf16_t* A; const bf16_t* Bt; int K; };
typedef float f32x2_t __attribute__((ext_vector_type(2)));
typedef __bf16 bf16x2_t __attribute__((ext_vector_type(2)));
__device__ __forceinline__ unsigned cvt_pk_bf16(float lo, float hi) { const f32x2_t v = {lo, hi}; const bf16x2_t r = __builtin_convertvector(v, bf16x2_t); return __builtin_bit_cast(unsigned, r); }

template <class Epi, class Sched, bool GATHER = false, int FP8SC = 0>
__device__ __forceinline__ void gemm_phase(PG8_LAS unsigned char* lds, const Gemm g, const Sched& S, const Epi& E, const PG8_LAS unsigned* gofs = nullptr) {
    const int tidx_ = ltid();
    const int tid = tidx_, wid = __builtin_amdgcn_readfirstlane(tid >> 6), lane = tid & 63, wr = wid >> 2, wc = wid & 3, fr = lane & 15, fq = lane >> 4;
    const int K = g.K, nt = K / BK;
    unsigned vA[2][2], nvA[2][2], voffB[2]; int RA[2], CA[2];
    const unsigned hstepu = (unsigned)HALF * (unsigned)K * 2u;
#pragma unroll
    for (int i = 0; i < 2; ++i) { int R, C; stage_rc(tid * 16 + i * 8192, R, C); const int Rb = Epi::PERM ? ((R & ~31) + perm32(R & 31)) : R; RA[i] = R; CA[i] = C;
        voffB[i] = (unsigned)(Rb * K + C) * 2u;
        if (GATHER) { vA[0][i] = gofs[R] + (unsigned)C * 2u; vA[1][i] = gofs[HALF + R] + (unsigned)C * 2u; }
        else { vA[0][i] = (unsigned)(R * K + C) * 2u; vA[1][i] = vA[0][i] + hstepu; }
        nvA[0][i] = vA[0][i]; nvA[1][i] = vA[1][i]; }
    const size_t kstep = (size_t)(BK * 2);
    const size_t hstep = (size_t)HALF * K * 2;
    const size_t tstep = 2 * hstep;
    const unsigned ldsw = (unsigned)wid * 1024u;
    const int aoff = lds_byte(wr * 64 + fr, fq * 8), boff = lds_byte(wc * 32 + fr, fq * 8);
#define PG8_SA(b, h) (((b) * 2 + (h)) * HTB)
#define PG8_SB(b, h) ((4 + (b) * 2 + (h)) * HTB)
#define PG8_STAGE(bufoff, gbase, voff) do { _Pragma("unroll") for (int _i = 0; _i < 2; ++_i) \
        __builtin_amdgcn_global_load_lds((const unsigned*)((const char*)(gbase) + (voff)[_i]), (PG8_LAS unsigned*)(lds + (bufoff) + ldsw + _i * 8192), 16, 0, 0); } while (0)
    typedef int v4i_ __attribute__((ext_vector_type(4))); typedef int v8i_ __attribute__((ext_vector_type(8)));
#define PG8_LDA(dst, dst8, b, h) do { _Pragma("unroll") for (int m = 0; m < 4; ++m) { if constexpr (FP8SC != 0) dst8[m] = __builtin_shufflevector(*(const PG8_LAS v4i_*)(lds + PG8_SA(b, h) + aoff + m * 2048), *(const PG8_LAS v4i_*)(lds + PG8_SA(b, h) + aoff + m * 2048 + 1024), 0, 1, 2, 3, 4, 5, 6, 7); \
        else { _Pragma("unroll") for (int k = 0; k < 2; ++k) dst[m][k] = *(const PG8_LAS bf16x8*)(lds + PG8_SA(b, h) + aoff + m * 2048 + k * 1024); } } } while (0)
#define PG8_LDB(dst, dst8, b, h) do { _Pragma("unroll") for (int n = 0; n < 2; ++n) { if constexpr (FP8SC != 0) dst8[n] = __builtin_shufflevector(*(const PG8_LAS v4i_*)(lds + PG8_SB(b, h) + boff + n * 2048), *(const PG8_LAS v4i_*)(lds + PG8_SB(b, h) + boff + n * 2048 + 1024), 0, 1, 2, 3, 4, 5, 6, 7); \
        else { _Pragma("unroll") for (int k = 0; k < 2; ++k) dst[n][k] = *(const PG8_LAS bf16x8*)(lds + PG8_SB(b, h) + boff + n * 2048 + k * 1024); } } } while (0)
#define PG8_MMA(ai, bj, At, At8, Bt, Bt8) do { __builtin_amdgcn_s_setprio(1); _Pragma("unroll") for (int m = 0; m < 4; ++m) _Pragma("unroll") for (int n = 0; n < 2; ++n) { \
        if constexpr (FP8SC != 0) asm volatile("v_mfma_scale_f32_16x16x128_f8f6f4 %0, %1, %2, %0, %3, %4 op_sel_hi:[0,0,0]" : "+v"(acc[ai][bj][m][n]) : "v"(Bt8[n]), "v"(At8[m]), "v"(scw), "v"(sca));   \
        else { _Pragma("unroll") for (int k = 0; k < 2; ++k) acc[ai][bj][m][n] = __builtin_amdgcn_mfma_f32_16x16x32_bf16(Bt[n][k], At[m][k], acc[ai][bj][m][n], 0, 0, 0); } } \
        __builtin_amdgcn_s_setprio(0); } while (0)
#define PG8_WAIT_V(n) asm volatile("s_waitcnt vmcnt(" #n ")" ::: "memory")
#define PG8_WAIT_L(n) asm volatile("s_waitcnt lgkmcnt(" #n ")" ::: "memory")
#define PG8_BAR __builtin_amdgcn_s_barrier()
#define PG8_SCHED __builtin_amdgcn_sched_barrier(0)
    Unit cur, nxt; int ui = 0;
    if (!S.next(0, cur)) return;
    f32x4 acc[2][2][4][2];
#pragma unroll
    for (int a = 0; a < 2; ++a)
#pragma unroll
        for (int b = 0; b < 2; ++b)
#pragma unroll
            for (int m = 0; m < 4; ++m)
#pragma unroll
                for (int n = 0; n < 2; ++n) acc[a][b][m][n] = (f32x4){0.f, 0.f, 0.f, 0.f};
    bf16x8 At[4][2], B0[2][2], B1[2][2]; v8i_ At8[4], B08[2], B18[2];
    int scw = (FP8SC & 0xff) * 0x01010101, sca = ((FP8SC >> 8) & 0xff) * 0x01010101;
    if constexpr (FP8SC != 0) asm volatile("" : "+v"(scw), "+v"(sca));
    const char* cA = (const char*)g.A + (GATHER ? (size_t)0 : (size_t)cur.pm * tstep); const char* cB = (const char*)g.Bt + (size_t)cur.pn * tstep;
    PG8_STAGE(PG8_SB(0, 0), cB, voffB); PG8_STAGE(PG8_SB(0, 1), cB + hstep, voffB); PG8_STAGE(PG8_SA(0, 0), cA, vA[0]); PG8_STAGE(PG8_SA(0, 1), cA, vA[1]);
    if (wr == 1) PG8_BAR;
    PG8_WAIT_V(2); PG8_BAR;
    PG8_STAGE(PG8_SB(1, 0), cB + kstep, voffB); PG8_STAGE(PG8_SA(1, 0), cA + kstep, vA[0]); PG8_STAGE(PG8_SB(1, 1), cB + hstep + kstep, voffB);
    PG8_WAIT_V(6); PG8_BAR;
    for (;;) {
        const bool has_next = S.next(ui + 1, nxt);
        const char* nA = (has_next && !GATHER) ? (const char*)g.A + (size_t)nxt.pm * tstep : cA; const char* nB = has_next ? (const char*)g.Bt + (size_t)nxt.pn * tstep : cB;
        for (int t = 0; t < nt; t += 2) {
            const bool last = (t == nt - 2);
            const char* a1 = cA + (size_t)(t + 1) * kstep;
            const char* a2 = last ? nA : cA + (size_t)(t + 2) * kstep; const char* b2 = last ? nB : cB + (size_t)(t + 2) * kstep;
            const char* a3 = a2 + kstep; const char* b3 = b2 + kstep;
            if (GATHER && last && has_next) {
#pragma unroll
                for (int i = 0; i < 2; ++i) { nvA[0][i] = gofs[(ui + 1) * 256 + RA[i]] + (unsigned)CA[i] * 2u; nvA[1][i] = gofs[(ui + 1) * 256 + HALF + RA[i]] + (unsigned)CA[i] * 2u; }
            }
            unsigned uA[2][2];
#pragma unroll
            for (int i = 0; i < 2; ++i) { uA[0][i] = last ? nvA[0][i] : vA[0][i]; uA[1][i] = last ? nvA[1][i] : vA[1][i]; }
            PG8_LDB(B0, B08, 0, 0); PG8_LDB(B1, B18, 0, 1); PG8_SCHED; PG8_LDA(At, At8, 0, 0); PG8_STAGE(PG8_SA(1, 1), a1, vA[1]);
            PG8_WAIT_V(8); PG8_WAIT_L(0); PG8_BAR; PG8_MMA(0, 0, At, At8, B0, B08); PG8_MMA(0, 1, At, At8, B1, B18); PG8_BAR; PG8_SCHED;
            PG8_LDA(At, At8, 0, 1); PG8_STAGE(PG8_SB(0, 0), b2, voffB); PG8_STAGE(PG8_SB(0, 1), b2 + hstep, voffB); PG8_STAGE(PG8_SA(0, 0), a2, uA[0]);
            PG8_WAIT_V(8); PG8_WAIT_L(0); PG8_BAR; PG8_MMA(1, 0, At, At8, B0, B08); PG8_MMA(1, 1, At, At8, B1, B18); PG8_BAR; PG8_SCHED;
            PG8_LDB(B0, B08, 1, 0); PG8_LDB(B1, B18, 1, 1); PG8_SCHED; PG8_LDA(At, At8, 1, 0); PG8_STAGE(PG8_SA(0, 1), a2, uA[1]);
            PG8_WAIT_V(8); PG8_WAIT_L(0); PG8_BAR; PG8_MMA(0, 0, At, At8, B0, B08); PG8_MMA(0, 1, At, At8, B1, B18); PG8_BAR; PG8_SCHED;
            PG8_LDA(At, At8, 1, 1); PG8_STAGE(PG8_SB(1, 0), b3, voffB); PG8_STAGE(PG8_SB(1, 1), b3 + hstep, voffB); PG8_STAGE(PG8_SA(1, 0), a3, uA[0]);
            PG8_WAIT_V(8); PG8_WAIT_L(0); PG8_BAR; PG8_MMA(1, 0, At, At8, B0, B08); PG8_MMA(1, 1, At, At8, B1, B18); PG8_BAR; PG8_SCHED;
        }
        if (wr == 0) PG8_BAR;
        if constexpr (FP8SC != 0) asm volatile("s_nop 15\n\ts_nop 15" ::: "memory");
        E(acc, cur, wr, wc, fr, fq);
        if (!has_next) break;
#pragma unroll
        for (int a = 0; a < 2; ++a)
#pragma unroll
            for (int b = 0; b < 2; ++b)
#pragma unroll
                for (int m = 0; m < 4; ++m)
#pragma unroll
                    for (int n = 0; n < 2; ++n) acc[a][b][m][n] = (f32x4){0.f, 0.f, 0.f, 0.f};
        cur = nxt; cA = nA; cB = nB; ++ui;
#pragma unroll
        for (int i = 0; i < 2; ++i) { vA[0][i] = nvA[0][i]; vA[1][i] = nvA[1][i]; }
        if (wr == 1) PG8_BAR;
    }
    PG8_WAIT_V(0);
    PG8_BAR;
#undef PG8_SA
#undef PG8_SB
#undef PG8_STAGE
#undef PG8_LDA
#undef PG8_LDB
#undef PG8_MMA
#undef PG8_WAIT_V
#undef PG8_WAIT_L
#undef PG8_BAR
#undef PG8_SCHED
}
}


typedef unsigned u32x2_t __attribute__((ext_vector_type(2)));
typedef _Float16 h4v_t __attribute__((ext_vector_type(4)));
typedef _Float16 h8v_t __attribute__((ext_vector_type(8)));
struct SchedDense {
    int nM, nN, nwg, G, c, m0;
    __device__ void init(int M, int N, int G_, int c_, int m0_ = 0) { nM = M / 256; nN = N / 256; nwg = nM * nN; G = G_; c = c_; m0 = m0_; }
    __device__ bool next(int i, pg8::Unit& u) const {
        const int L = i * G + c; if (L >= nwg) return false;
        int wgid = L; { const int q = nwg / 8, r = nwg % 8, xcd = wgid % 8, off = wgid / 8; wgid = (xcd < r ? xcd * (q + 1) : r * (q + 1) + (xcd - r) * q) + off; }
        const int nig = 8 * nN, gid = wgid / nig, fm = gid * 8, gsz = (nM - fm) < 8 ? (nM - fm) : 8;
        u.pm = m0 + fm + ((wgid % nig) % gsz); u.pn = (wgid % nig) / gsz; return true;
    }
};
struct EpiWin {
    static constexpr bool PERM = true;
    unsigned char* ws; const float* lb;
    __device__ __forceinline__ void operator()(const pg8::f32x4 (&acc)[2][2][4][2], const pg8::Unit& u, int wr, int wc, int fr, int fq) const {
        const int row0 = u.pm * 256 + wr * 64 + fr, ct = u.pn, colw = (ct & 1) * 256 + wc * 32 + 8 * fq;
        if (ct >= 6 && ct <= 9) {
            unsigned short* PF = (unsigned short*)(ws + RC_PF); const int cg = (ct - 6) * 256 + wc * 32 + 8 * fq;
#pragma unroll
            for (int bj = 0; bj < 2; ++bj) {
                const int col = cg + bj * 128; const pg8::f32x4 l0 = *(const pg8::f32x4*)(lb + col), l1 = *(const pg8::f32x4*)(lb + col + 4);
#pragma unroll
                for (int ai = 0; ai < 2; ++ai)
#pragma unroll
                    for (int m = 0; m < 4; ++m) { const pg8::f32x4 v0 = acc[ai][bj][m][0], v1 = acc[ai][bj][m][1]; h8v_t hv;
#pragma unroll
                        for (int j = 0; j < 4; ++j) { hv[j] = (_Float16)__builtin_amdgcn_logf(l0[j] + (1.0f - l0[j]) * __builtin_amdgcn_rcpf(1.0f + __expf(-v0[j]))); hv[4 + j] = (_Float16)__builtin_amdgcn_logf(l1[j] + (1.0f - l1[j]) * __builtin_amdgcn_rcpf(1.0f + __expf(-v1[j]))); }
                        *(h8v_t*)(PF + (size_t)(row0 + ai * 128 + m * 16) * 1024 + col) = hv; }
            }
        } else {
            if (ct < 2 && u.pm >= 64) return;
            pg8::bf16_t* O = (pg8::bf16_t*)(ws + (ct < 2 ? WS_PU : (ct < 4 ? RC_PQ : (ct < 6 ? RC_PV : RC_PG))));
#pragma unroll
            for (int bj = 0; bj < 2; ++bj) {
                const int col = colw + bj * 128;
#pragma unroll
                for (int ai = 0; ai < 2; ++ai)
#pragma unroll
                    for (int m = 0; m < 4; ++m) { pg8::f32x4 v0 = acc[ai][bj][m][0], v1 = acc[ai][bj][m][1];
                        if (ct == 2 || ct == 3) {
#pragma unroll
                            for (int j = 0; j < 4; ++j) { v0[j] = v0[j] * __builtin_amdgcn_rcpf(1.0f + __expf(-v0[j])); v1[j] = v1[j] * __builtin_amdgcn_rcpf(1.0f + __expf(-v1[j])); } }
                        pg8::u32x4 w; w.x = pg8::cvt_pk_bf16(v0[0], v0[1]); w.y = pg8::cvt_pk_bf16(v0[2], v0[3]); w.z = pg8::cvt_pk_bf16(v1[0], v1[1]); w.w = pg8::cvt_pk_bf16(v1[2], v1[3]);
                        *(pg8::u32x4*)(O + (size_t)(row0 + ai * 128 + m * 16) * 512 + col) = w; }
            }
        }
    }
};
struct EpiWout {
    static constexpr bool PERM = true;
    _Float16* X1; const float* x; const float* mod;
    __device__ __forceinline__ void operator()(const pg8::f32x4 (&acc)[2][2][4][2], const pg8::Unit& u, int wr, int wc, int fr, int fq) const {
        const int row0 = u.pm * 256 + wr * 64 + fr, col0 = u.pn * 256 + wc * 32 + 8 * fq; const float* gt = mod + (u.pm >> 5) * 6144 + 2048;
#pragma unroll
        for (int bj = 0; bj < 2; ++bj) {
            const int col = col0 + bj * 128; const pg8::f32x4 g0 = *(const pg8::f32x4*)(gt + col), g1 = *(const pg8::f32x4*)(gt + col + 4);
#pragma unroll
            for (int ai = 0; ai < 2; ++ai)
#pragma unroll
                for (int m = 0; m < 4; ++m) { const size_t o = (size_t)(row0 + ai * 128 + m * 16) * D_ + col;
                    const pg8::f32x4 v0 = __builtin_nontemporal_load((const pg8::f32x4*)(x + o)) + g0 * acc[ai][bj][m][0], v1 = __builtin_nontemporal_load((const pg8::f32x4*)(x + o + 4)) + g1 * acc[ai][bj][m][1];
                    h8v_t hv; hv[0] = (_Float16)v0[0]; hv[1] = (_Float16)v0[1]; hv[2] = (_Float16)v0[2]; hv[3] = (_Float16)v0[3]; hv[4] = (_Float16)v1[0]; hv[5] = (_Float16)v1[1]; hv[6] = (_Float16)v1[2]; hv[7] = (_Float16)v1[3];
                    *(h8v_t*)(X1 + o) = hv; }
        }
    }
};
struct SchedGU {
    int G, c;
    __device__ bool next(int i, pg8::Unit& u) const {
        const int L = i * G + c; if (L >= 2816) return false;
        const int r = L >> 8, cc = L & 255, xcd = cc & 7, j = cc >> 3, mt = j & 7, ntl = j >> 3, q = (r * 8 + xcd) * 4 + ntl, e = q / 22;
        u.pm = e * 8 + mt; u.pn = q; return true;
    }
};
struct SchedDown {
    int G, c;
    __device__ bool next(int i, pg8::Unit& u) const {
        const int L = i * G + c; if (L >= 512) return false;
        const int r = L >> 8, cc = L & 255, xcd = cc & 7, j = cc >> 3, mt = j & 7, nt = j >> 3, e = r * 8 + xcd;
        u.pm = e * 8 + mt; u.pn = e * 4 + nt; return true;
    }
};
__device__ __forceinline__ unsigned pk4_fp8(float a, float b, float c, float d) { unsigned w = 0u; w = __builtin_amdgcn_cvt_pk_fp8_f32(a, b, w, false); w = __builtin_amdgcn_cvt_pk_fp8_f32(c, d, w, true); return w; }
struct EpiGU {
    static constexpr bool PERM = true;
    unsigned char* HID;
    __device__ __forceinline__ void operator()(const pg8::f32x4 (&acc)[2][2][4][2], const pg8::Unit& u, int wr, int wc, int fr, int fq) const {
        typedef float f2_t __attribute__((ext_vector_type(2)));
        const int row0 = u.pm * 256 + wr * 64 + fr, col0 = (u.pn % 22) * 128 + wc * 32 + 8 * fq;
#pragma unroll
        for (int ai = 0; ai < 2; ++ai)
#pragma unroll
            for (int m = 0; m < 4; ++m) {
                float h[8];
#pragma unroll
                for (int n = 0; n < 2; ++n)
#pragma unroll
                    for (int j = 0; j < 4; j += 2) {
                        const f2_t gv = {acc[ai][0][m][n][j], acc[ai][0][m][n][j + 1]}, uv = {acc[ai][1][m][n][j], acc[ai][1][m][n][j + 1]};
                        const f2_t a = gv * -1.44269504f;
                        const f2_t t = {__builtin_amdgcn_exp2f(a.x), __builtin_amdgcn_exp2f(a.y)};
                        const f2_t d = t * 0.125f + 0.125f;
                        const f2_t r = {__builtin_amdgcn_rcpf(d.x), __builtin_amdgcn_rcpf(d.y)};
                        const f2_t hv = (gv * uv) * r;
                        h[n * 4 + j] = __builtin_amdgcn_fmed3f(hv.x, -448.0f, 448.0f); h[n * 4 + j + 1] = __builtin_amdgcn_fmed3f(hv.y, -448.0f, 448.0f);
                    }
                u32x2_t w; w.x = pk4_fp8(h[0], h[1], h[2], h[3]); w.y = pk4_fp8(h[4], h[5], h[6], h[7]);
                *(u32x2_t*)(HID + (size_t)(row0 + ai * 128 + m * 16) * DE_ + col0) = w;
            }
    }
};
struct EpiDown {
    static constexpr bool PERM = true;
    pg8::bf16_t* YE; const float* GATER;
    __device__ __forceinline__ void operator()(const pg8::f32x4 (&acc)[2][2][4][2], const pg8::Unit& u, int wr, int wc, int fr, int fq) const {
        const int row0 = u.pm * 256 + wr * 64 + fr, col0 = (u.pn & 3) * 256 + wc * 32 + 8 * fq;
#pragma unroll
        for (int ai = 0; ai < 2; ++ai)
#pragma unroll
            for (int m = 0; m < 4; ++m) {
                const int row = row0 + ai * 128 + m * 16; const float gt = GATER[row];
#pragma unroll
                for (int bj = 0; bj < 2; ++bj) { const pg8::f32x4 v0 = acc[ai][bj][m][0] * gt, v1 = acc[ai][bj][m][1] * gt;
                    pg8::u32x4 w; w.x = pg8::cvt_pk_bf16(v0[0], v0[1]); w.y = pg8::cvt_pk_bf16(v0[2], v0[3]); w.z = pg8::cvt_pk_bf16(v1[0], v1[1]); w.w = pg8::cvt_pk_bf16(v1[2], v1[3]);
                    *(pg8::u32x4*)(YE + (size_t)row * D_ + col0 + bj * 128) = w; }
            }
    }
};

template <class RowFn>
__device__ __forceinline__ void transpose_item(const float* W, int N, int k0, int n0, const RowFn& dst, PG8_LAS unsigned* scr, int lane) {
    const int r = lane >> 4, n4 = lane & 15;
    float4 v[16];
#pragma unroll
    for (int i = 0; i < 16; ++i) { const int k = 8 * (i >> 1) + 2 * r + (i & 1); v[i] = *(const float4*)(W + (size_t)(k0 + k) * N + n0 + n4 * 4); }
#pragma unroll
    for (int j = 0; j < 8; ++j) {
        const int kp = 4 * j + r; PG8_LAS unsigned* t = scr + (n4 * 4) * 33 + kp;
        t[0] = pg8::cvt_pk_bf16(v[2 * j].x, v[2 * j + 1].x); t[33] = pg8::cvt_pk_bf16(v[2 * j].y, v[2 * j + 1].y);
        t[66] = pg8::cvt_pk_bf16(v[2 * j].z, v[2 * j + 1].z); t[99] = pg8::cvt_pk_bf16(v[2 * j].w, v[2 * j + 1].w);
    }
    asm volatile("s_waitcnt lgkmcnt(0)" ::: "memory");
    const int c8 = lane & 7;
#pragma unroll
    for (int jj = 0; jj < 8; ++jj) {
        const int n = (lane >> 3) + 8 * jj; const PG8_LAS unsigned* t = scr + n * 33 + 4 * c8;
        uint4 o; o.x = t[0]; o.y = t[1]; o.z = t[2]; o.w = t[3];
        *(uint4*)(dst(n0 + n) + k0 + 8 * c8) = o;
    }
    asm volatile("s_waitcnt lgkmcnt(0)" ::: "memory");
}
struct RowGU { pg8::bf16_t* base; int up; __device__ pg8::bf16_t* operator()(int f) const { return base + ((size_t)(f >> 7) * 256 + up * 128 + (f & 127)) * 1024; } };
struct RowPlain { pg8::bf16_t* base; int K; __device__ pg8::bf16_t* operator()(int n) const { return base + (size_t)n * K; } };
struct CvItem { const float* W; unsigned char* base; int N, k0, n0, A, Kd; };
struct CvSrc { const float *wg, *wu, *wd; unsigned char *wgu, *wdt; };
__device__ __forceinline__ CvItem moe_item(const CvSrc q, int it) {
    constexpr int IG = 8 * 88, ID = 22 * 32;
    const int e = it / (2 * IG + ID), r = it - e * (2 * IG + ID);
    const bool isd = r >= 2 * IG, up = (r >= IG) && !isd;
    const int r2 = r - (isd ? 2 * IG : (up ? IG : 0));
    const int kbg = r2 / 88, nbg = r2 - kbg * 88, kbd = r2 >> 5, nbd = r2 & 31;
    CvItem c;
    const float* wsel = isd ? q.wd : (up ? q.wu : q.wg);
    c.W = wsel + (size_t)e * D_ * DE_;
    c.N = isd ? D_ : DE_; c.k0 = (isd ? kbd : kbg) * 128; c.n0 = (isd ? nbd : nbg) * 32;
    c.base = (isd ? q.wdt : q.wgu) + (isd ? (size_t)e * 1024 * DE_ : ((size_t)e * 22 * 256 + (up ? 128 : 0)) * 1024);
    c.A = isd ? 128 : 256; c.Kd = isd ? DE_ : 1024;
    return c;
}
__device__ __forceinline__ void cv_load(const CvItem& c, pg8::f32x4 (&v)[16], int lane) {
    const int r = lane >> 3, n4 = lane & 7;
#pragma unroll
    for (int i = 0; i < 16; ++i) { const int k = 32 * (i >> 2) + 4 * r + (i & 3); v[i] = __builtin_nontemporal_load((const pg8::f32x4*)(c.W + (size_t)(c.k0 + k) * c.N + c.n0 + n4 * 4)); }
}
__device__ __forceinline__ void cv_store(const CvItem& c, const pg8::f32x4 (&v)[16], PG8_LAS unsigned* scr, int lane) {
    const int r = lane >> 3, n4 = lane & 7;
#pragma unroll
    for (int j = 0; j < 4; ++j) {
        PG8_LAS unsigned* t = scr + (n4 * 4) * 34 + 8 * j + r;
#pragma unroll
        for (int cc = 0; cc < 4; ++cc) t[34 * cc] = pk4_fp8(__builtin_amdgcn_fmed3f(v[4 * j][cc] * 64.0f, -448.f, 448.f), __builtin_amdgcn_fmed3f(v[4 * j + 1][cc] * 64.0f, -448.f, 448.f), __builtin_amdgcn_fmed3f(v[4 * j + 2][cc] * 64.0f, -448.f, 448.f), __builtin_amdgcn_fmed3f(v[4 * j + 3][cc] * 64.0f, -448.f, 448.f));
    }
    asm volatile("s_waitcnt lgkmcnt(0)" ::: "memory");
    const int c8 = lane & 7;
#pragma unroll
    for (int jj = 0; jj < 4; ++jj) {
        const int n = (lane >> 3) + 8 * jj, nn = c.n0 + n; const PG8_LAS unsigned* t = scr + n * 34 + 4 * c8;
        pg8::u32x4 o; o.x = t[0]; o.y = t[1]; o.z = t[2]; o.w = t[3];
        __builtin_nontemporal_store(o, (pg8::u32x4*)(c.base + ((size_t)(nn >> 7) * c.A + (nn & 127)) * c.Kd + c.k0 + 16 * c8));
    }
    asm volatile("s_waitcnt lgkmcnt(0)" ::: "memory");
}
__device__ void st_convert_moe(KP p, PG8_LAS unsigned* ldsw, int bid, int nb, const int NIT) {
    const int tidx_ = ltid();
    const int lane = tidx_ & 63, wv = __builtin_amdgcn_readfirstlane(tidx_ >> 6), gw = bid * 8 + wv, nw = nb * 8;
    PG8_LAS unsigned* scr = ldsw + wv * 2112;
    if (gw >= NIT) return;
    const CvSrc cs{p->w_g, p->w_u, p->w_d, p->ws + WS_WGU, p->ws + WS_WD};
    pg8::f32x4 va[16], vb[16];
    CvItem ca = moe_item(cs, gw); cv_load(ca, va, lane);
    for (int it = gw; it < NIT; it += 2 * nw) {
        const int itb = it + nw, itbc = itb < NIT ? itb : it;
        const CvItem cb = moe_item(cs, itbc); cv_load(cb, vb, lane);
        cv_store(ca, va, scr, lane);
        const int ita = itb + nw, itac = ita < NIT ? ita : it;
        ca = moe_item(cs, itac); cv_load(ca, va, lane);
        if (itb < NIT) cv_store(cb, vb, scr, lane);
    }
}
__device__ void st_convert_tail(KP p, PG8_LAS unsigned* ldsw, int bid, int nb, int it_lo, int it_hi) {
    const int tidx_ = ltid();
    const int lane = tidx_ & 63, wv = __builtin_amdgcn_readfirstlane(tidx_ >> 6), gw = bid * 8 + wv, nw = nb * 8;
    PG8_LAS unsigned* scr = ldsw + wv * 2112;
    const CvSrc cs{p->w_g, p->w_u, p->w_d, p->ws + WS_WGU, p->ws + WS_WD};
    for (int it = it_lo + gw; it < it_hi; it += nw) { const CvItem c = moe_item(cs, it); pg8::f32x4 v[16]; cv_load(c, v, lane); cv_store(c, v, scr, lane); }
}
__device__ void st_convert_dense(KP p, PG8_LAS unsigned* ldsw, int bid, int nb) {
    const int tidx_ = ltid();
    const int lane = tidx_ & 63, wv = tidx_ >> 6, gw = bid * 8 + wv, nw = nb * 8;
    PG8_LAS unsigned* scr = ldsw + wv * 2112;
    constexpr int II = 16 * 48, IO = 16 * 16;
    for (int it = gw; it < II + IO; it += nw) {
        if (it < II) { RowPlain fn{(pg8::bf16_t*)(p->ws + WS_WINT), D_}; transpose_item(p->w_in, DIN_, (it / 48) * 64, (it % 48) * 64, fn, scr, lane); }
        else { const int r = it - II; RowPlain fn{(pg8::bf16_t*)(p->ws + WS_WOUTT), D_}; transpose_item(p->w_out, D_, (r / 16) * 64, (r % 16) * 64, fn, scr, lane); }
    }
}
__device__ void st_gather(KP p, int bid, int nb) {
    const int tidx_ = ltid();
    const int* IDXR = (const int*)(p->ws + WS_IDX); const uint4* H2B = (const uint4*)(p->ws + RC_H2B); uint4* XS = (uint4*)(p->ws + RC_XS);
    const int lane = tidx_ & 63, gw = bid * 8 + (tidx_ >> 6), nw = nb * 8;
    for (int row = gw; row < 32768; row += nw) {
        const int e = row >> 11, bb = (row >> 10) & 1, c = row & 1023; const int t = IDXR[(bb * 16 + e) * 1024 + c];
        XS[(size_t)row * 64 + lane] = H2B[(size_t)(bb * L_ + t) * 64 + lane];
    }
}


__device__ __forceinline__ pg8::bf16_t f2bf(float v) { return (pg8::bf16_t)(pg8::cvt_pk_bf16(v, 0.f) & 0xffffu); }
__device__ void st_dft_consts(KP p, PG8_LAS float* tc, int bid, int nb) {
    const int tidx_ = ltid();
    pg8::bf16_t* W12T = (pg8::bf16_t*)(p->ws + WS_W12T); pg8::bf16_t* FA = (pg8::bf16_t*)(p->ws + WS_FA); pg8::bf16_t* FC = (pg8::bf16_t*)(p->ws + WS_FC);
    const int gt = bid * 512 + tidx_, nt = nb * 512;
    __syncthreads();
    if (tidx_ < 128) { tc[tidx_] = cospif((float)tidx_ / 64.0f); tc[128 + tidx_] = sinpif((float)tidx_ / 64.0f); }
    __syncthreads();
    for (int base = bid * 512; base < 4 * 256 * 128; base += nb * 512) {
        const int g = base >> 15, r0 = (base >> 7) & 255, d0 = r0 & 127, to = r0 < 128 ? 0 : 128;
        __syncthreads();
        tc[256 + (tidx_ & 3) * 128 + (tidx_ >> 2)] = p->w_f[(g * 128 + (tidx_ >> 2)) * 128 + d0 + (tidx_ & 3)];
        __syncthreads();
        const int rl = tidx_ >> 7, c = tidx_ & 127; float acc = 0.f;
#pragma unroll 8
        for (int m = 0; m < 128; ++m) acc = fmaf(tc[to + ((m * c) & 127)], tc[256 + rl * 128 + m], acc);
        W12T[base + tidx_] = f2bf(r0 < 128 ? acc : -acc);
    }
    for (int i = gt; i < 256 * 256; i += nt) {
        const int r = i >> 8, kk = i & 255, k1 = r & 127, l1 = kk >> 1, im_in = kk & 1, a = (k1 * l1) & 127;
        const float C = tc[a], S = tc[128 + a]; float v;
        if (r < 128) v = im_in ? S : C; else v = im_in ? C : -S;
        FA[i] = f2bf(v * (1.0f / 16.0f));
    }
    for (int i = gt; i < 64 * 128; i += nt) {
        const int k2 = i >> 7, kk = i & 127, l2 = kk >> 1, a = ((k2 * l2) & 63) * 2;
        FC[i] = f2bf(((kk & 1) ? tc[128 + a] : tc[a]) * (1.0f / 64.0f));
    }
    __syncthreads();
}
__device__ __forceinline__ pg8::bf16x8 ld16(const pg8::bf16_t* q) { return *(const pg8::bf16x8*)q; }
__device__ void st_dft0(KP p, PG8_LAS unsigned char* lds, int bid, int nb) {
    const int tidx_ = ltid();
    const pg8::bf16_t* PU = (const pg8::bf16_t*)(p->ws + WS_PU); const pg8::bf16_t* W12T = (const pg8::bf16_t*)(p->ws + WS_W12T); unsigned* X = (unsigned*)(p->ws + RC_XF);
    const int lane = tidx_ & 63, wv = tidx_ >> 6, n = lane & 15, q = lane >> 4;
    for (int grp = bid; grp < 256; grp += nb) {
        const int g = grp >> 6, b = (grp >> 5) & 1, l2b = (grp & 31) * 2;
        pg8::u32x4 st[8];
#pragma unroll
        for (int i = 0; i < 8; ++i) { const int pc = tidx_ + 512 * i, row = pc >> 4, c16 = pc & 15, it = row >> 4, tn = row & 15, l2 = l2b + (it >> 3), l1t = it & 7;
            st[i] = *(const pg8::u32x4*)(PU + ((size_t)(b * L_ + 64 * (l1t * 16 + tn) + l2)) * 512 + g * 128 + c16 * 8); }
        pg8::bf16x8 Fre[4], Fim[4];
#pragma unroll
        for (int ks = 0; ks < 4; ++ks) { Fre[ks] = ld16(W12T + ((size_t)(g * 256 + 16 * wv + n)) * 128 + ks * 32 + 8 * q); Fim[ks] = ld16(W12T + ((size_t)(g * 256 + 128 + 16 * wv + n)) * 128 + ks * 32 + 8 * q); }
        __syncthreads();
#pragma unroll
        for (int i = 0; i < 8; ++i) { const int pc = tidx_ + 512 * i; *(PG8_LAS pg8::u32x4*)(lds + (pc >> 4) * 272 + (pc & 15) * 16) = st[i]; }
        __syncthreads();
#pragma unroll 2
        for (int it = 0; it < 16; ++it) {
            const int l2 = l2b + (it >> 3), l1t = it & 7;
            pg8::f32x4 ar = (pg8::f32x4){0.f, 0.f, 0.f, 0.f}, ai = ar;
#pragma unroll
            for (int ks = 0; ks < 4; ++ks) { const pg8::bf16x8 bf = *(const PG8_LAS pg8::bf16x8*)(lds + (it * 16 + n) * 272 + (ks * 32 + 8 * q) * 2);
                ar = __builtin_amdgcn_mfma_f32_16x16x32_bf16(Fre[ks], bf, ar, 0, 0, 0); ai = __builtin_amdgcn_mfma_f32_16x16x32_bf16(Fim[ks], bf, ai, 0, 0, 0); }
#pragma unroll
            for (int r = 0; r < 4; ++r) { const int d = 16 * wv + 4 * q + r; X[((size_t)((b * 64 + l2) * 512 + g * 128 + d)) * 128 + l1t * 16 + n] = pg8::cvt_pk_bf16(ar[r], ai[r]); }
        }
    }
    __syncthreads();
}
__device__ void st_dftA(KP p, PG8_LAS unsigned char* lds, int bid, int nb) {
    const int tidx_ = ltid();
    const pg8::bf16_t* X = (const pg8::bf16_t*)(p->ws + RC_XF); const pg8::bf16_t* FA = (const pg8::bf16_t*)(p->ws + WS_FA); const float* CS = (const float*)(p->ws + WS_COS); unsigned* Y = (unsigned*)(p->ws + RC_YF);
    const int lane = tidx_ & 63, wv = tidx_ >> 6, n = lane & 15, q = lane >> 4;
    pg8::bf16x8 Fre[8], Fim[8];
#pragma unroll
    for (int ks = 0; ks < 8; ++ks) { Fre[ks] = ld16(FA + (size_t)(16 * wv + n) * 256 + ks * 32 + 8 * q); Fim[ks] = ld16(FA + (size_t)(128 + 16 * wv + n) * 256 + ks * 32 + 8 * q); }
    for (int grp = bid; grp < 256; grp += nb) {
        const int l2t = grp >> 6, b = (grp >> 5) & 1, gd0 = (grp & 31) * 16, l2 = l2t * 16 + n;
        float ct[4], st[4];
#pragma unroll
        for (int r = 0; r < 4; ++r) { const int idx = (16 * wv + 4 * q + r) * l2; ct[r] = CS[idx]; st[r] = CS[(idx - 2048) & 8191]; }
        pg8::u32x4 sg[8];
#pragma unroll
        for (int i = 0; i < 8; ++i) { const int pc = tidx_ + 512 * i, row = pc >> 5, c16 = pc & 31;
            sg[i] = *(const pg8::u32x4*)(X + ((size_t)((b * 64 + l2t * 16 + (row & 15)) * 512 + gd0 + (row >> 4))) * 256 + c16 * 8); }
#pragma unroll 1
        for (int half = 0; half < 2; ++half) {
            __syncthreads();
#pragma unroll
            for (int i = 0; i < 8; ++i) { const int pc = tidx_ + 512 * i; *(PG8_LAS pg8::u32x4*)(lds + (pc >> 5) * 528 + (pc & 31) * 16) = sg[i]; }
            __syncthreads();
            if (half == 0) {
#pragma unroll
                for (int i = 0; i < 8; ++i) { const int pc = tidx_ + 512 * i, row = pc >> 5, c16 = pc & 31;
                    sg[i] = *(const pg8::u32x4*)(X + ((size_t)((b * 64 + l2t * 16 + (row & 15)) * 512 + gd0 + 8 + (row >> 4))) * 256 + c16 * 8); }
            }
#pragma unroll 2
            for (int gi = 0; gi < 8; ++gi) {
                const int gd = gd0 + half * 8 + gi;
                pg8::f32x4 ar = (pg8::f32x4){0.f, 0.f, 0.f, 0.f}, ai = ar;
#pragma unroll
                for (int ks = 0; ks < 8; ++ks) { const pg8::bf16x8 bf = *(const PG8_LAS pg8::bf16x8*)(lds + (gi * 16 + n) * 528 + (ks * 32 + 8 * q) * 2);
                    ar = __builtin_amdgcn_mfma_f32_16x16x32_bf16(Fre[ks], bf, ar, 0, 0, 0); ai = __builtin_amdgcn_mfma_f32_16x16x32_bf16(Fim[ks], bf, ai, 0, 0, 0); }
#pragma unroll
                for (int r = 0; r < 4; ++r) { const int k1 = 16 * wv + 4 * q + r; const float yr = ar[r] * ct[r] + ai[r] * st[r], yi = ai[r] * ct[r] - ar[r] * st[r];
                    Y[((size_t)((b * 128 + k1) * 512 + gd)) * 64 + l2] = pg8::cvt_pk_bf16(yr, yi); }
            }
        }
    }
    __syncthreads();
}
__device__ void st_dftC(KP p, int bid, int nb) {
    const int tidx_ = ltid();
    const pg8::bf16_t* Y = (const pg8::bf16_t*)(p->ws + RC_YF); const pg8::bf16_t* FC = (const pg8::bf16_t*)(p->ws + WS_FC); pg8::bf16_t* MIX = (pg8::bf16_t*)(p->ws + RC_MIX);
    const int lane = tidx_ & 63, wv = tidx_ >> 6, n = lane & 15, q = lane >> 4, gw = bid * 8 + wv, nw = nb * 8;
    pg8::bf16x8 F[4][4];
#pragma unroll
    for (int mt = 0; mt < 4; ++mt)
#pragma unroll
        for (int ks = 0; ks < 4; ++ks) F[mt][ks] = ld16(FC + (size_t)(16 * mt + n) * 128 + ks * 32 + 8 * q);
    for (int t0 = gw * 2; t0 < 8192; t0 += nw * 2) {
        pg8::bf16x8 Bf[2][4];
#pragma unroll
        for (int i = 0; i < 2; ++i) { const int t = t0 + i; const pg8::bf16_t* row = Y + ((size_t)((t >> 3) * 128 + (t & 7) * 16 + n)) * 128 + 8 * q;
#pragma unroll
            for (int ks = 0; ks < 4; ++ks) Bf[i][ks] = ld16(row + ks * 32); }
#pragma unroll
        for (int i = 0; i < 2; ++i) { const int t = t0 + i, bk = t >> 5, g = (t >> 3) & 3, d = (t & 7) * 16 + n, b = bk >> 7, k1 = bk & 127;
#pragma unroll
            for (int mt = 0; mt < 4; ++mt) { pg8::f32x4 a = (pg8::f32x4){0.f, 0.f, 0.f, 0.f};
#pragma unroll
                for (int ks = 0; ks < 4; ++ks) a = __builtin_amdgcn_mfma_f32_16x16x32_bf16(F[mt][ks], Bf[i][ks], a, 0, 0, 0);
#pragma unroll
                for (int r = 0; r < 4; ++r) { const int k = k1 + 128 * (16 * mt + 4 * q + r); MIX[((size_t)(b * L_ + k)) * D_ + g * 128 + d] = f2bf(a[r]); } } }
    }
}


constexpr int SC_T = 0, SC_GX = 2048, SC_QH = 4096, SC_QT = 21504, SC_KH = 38912, SC_KT = 82432, SC_VT = 100864, SC_A = 119296, SC_RS = 272, SC_RS64 = 144;
template <bool OUT>
__device__ __forceinline__ void scan_task(unsigned char* wsb, PG8_LAS unsigned char* lds, int dir, int b, int h, bool ctx, int pos0, int nch, pg8::f32x4 (&S)[8], float& glog, pg8::bf16_t* O) {
    const int tidx_ = ltid();
    const int tid = tidx_, ch = tid & 127, lane = tid & 63, w = __builtin_amdgcn_readfirstlane(tid >> 6), J = w >> 1, r = lane & 15, quad = lane >> 4;
    PG8_LAS float* T = (PG8_LAS float*)(lds + SC_T); PG8_LAS float* GX = (PG8_LAS float*)(lds + SC_GX);
    if (OUT) {
        if (tid < 128) { const int blk = tid >> 6, rr = (tid >> 2) & 15, cc = tid & 3; *(PG8_LAS unsigned long long*)(lds + SC_A + (32 * blk + rr) * SC_RS64 + (32 * blk + 16 + 4 * cc) * 2) = 0ull; }
    }
    float lf[16]; unsigned vr[16], qr[16];
#define SCAN_LOADS(cc, LF, VR, QR) do { _Pragma("unroll") for (int ii = 0; ii < 16; ++ii) { \
        const int pos = pos0 + 64 * (cc) + 16 * J + ii; \
        const int row = ctx ? (RL_ + b * CTX_ + (dir ? CTX_ - 1 - pos : pos)) : (b * L_ + (dir ? L_ - 1 - pos : pos)); \
        LF[ii] = (float)((const _Float16*)(wsb + RC_PF))[(size_t)row * 1024 + dir * 512 + h * 128 + ch]; \
        VR[ii] = ((const pg8::bf16_t*)(wsb + RC_PV))[(size_t)row * 512 + h * 128 + ch]; \
        if (OUT) QR[ii] = ((const pg8::bf16_t*)(wsb + RC_PQ))[(size_t)row * 512 + h * 128 + ch]; } } while (0)
    SCAN_LOADS(0, lf, vr, qr);
    float cs[16];
    { float run = 0.f;
#pragma unroll
      for (int ii = 0; ii < 16; ++ii) { run += lf[ii]; cs[ii] = run; lf[ii] = 1.f - __builtin_amdgcn_exp2f(lf[ii]); }
      T[J * 128 + ch] = run; }
    __syncthreads();
    for (int c = 0; c < nch; ++c) {
        float qv[16], vv[16];
#pragma unroll
        for (int ii = 0; ii < 16; ++ii) { vv[ii] = __uint_as_float(vr[ii] << 16); if (OUT) qv[ii] = __uint_as_float(qr[ii] << 16); }
        const float t0 = T[ch], t1 = T[128 + ch], t2 = T[256 + ch], t3 = T[384 + ch];
        const float ref1 = t0, ref2 = t0 + t1, ref3 = ref2 + t2, gtot = ref3 + t3;
        const float myref = (J == 0) ? 0.f : (J == 1 ? ref1 : (J == 2 ? ref2 : ref3));
        if (J == 0) GX[ch] = __builtin_amdgcn_exp2f(gtot);
        const float gprev = glog;
        glog += gtot;
        {
            unsigned pv[8], pk[8]; const float eg = gtot - myref;
#pragma unroll
            for (int i2 = 0; i2 < 8; ++i2) {
                pv[i2] = pg8::cvt_pk_bf16(vv[2 * i2], vv[2 * i2 + 1]);
                pk[i2] = pg8::cvt_pk_bf16(lf[2 * i2] * __builtin_amdgcn_exp2f(eg - cs[2 * i2]), lf[2 * i2 + 1] * __builtin_amdgcn_exp2f(eg - cs[2 * i2 + 1]));
            }
            PG8_LAS pg8::u32x4* dv = (PG8_LAS pg8::u32x4*)(lds + SC_VT + ch * SC_RS64 + 32 * J); dv[0] = (pg8::u32x4){pv[0], pv[1], pv[2], pv[3]}; dv[1] = (pg8::u32x4){pv[4], pv[5], pv[6], pv[7]};
            PG8_LAS pg8::u32x4* dk = (PG8_LAS pg8::u32x4*)(lds + SC_KT + ch * SC_RS64 + 32 * J); dk[0] = (pg8::u32x4){pk[0], pk[1], pk[2], pk[3]}; dk[1] = (pg8::u32x4){pk[4], pk[5], pk[6], pk[7]};
        }
        if (OUT) {
            const float eG = __builtin_amdgcn_exp2f(gprev);
#pragma unroll
            for (int i2 = 0; i2 < 8; ++i2) {
                const float eb0 = __builtin_amdgcn_exp2f(fmaxf(myref + cs[2 * i2], -115.f)), eb1 = __builtin_amdgcn_exp2f(fmaxf(myref + cs[2 * i2 + 1], -115.f));
                const float qh0 = qv[2 * i2] * eb0, qh1 = qv[2 * i2 + 1] * eb1;
                const unsigned pq = pg8::cvt_pk_bf16(qh0, qh1), pkk = pg8::cvt_pk_bf16(lf[2 * i2] * __builtin_amdgcn_rcpf(eb0), lf[2 * i2 + 1] * __builtin_amdgcn_rcpf(eb1)), pt = pg8::cvt_pk_bf16(qh0 * eG, qh1 * eG);
                const int j = 16 * J + 2 * i2;
                { const int pos = pos0 + 64 * c + j; const int row = b * L_ + (dir ? L_ - 1 - pos : pos); const int row1 = dir ? row - 1 : row + 1;
                  ((pg8::bf16_t*)(wsb + RC_PF))[(size_t)row * 1024 + dir * 512 + h * 128 + ch] = (pg8::bf16_t)(pt & 0xffffu);
                  ((pg8::bf16_t*)(wsb + RC_PF))[(size_t)row1 * 1024 + dir * 512 + h * 128 + ch] = (pg8::bf16_t)(pt >> 16); }
                *(PG8_LAS pg8::bf16_t*)(lds + SC_QH + j * SC_RS + ch * 2) = (pg8::bf16_t)(pq & 0xffffu); *(PG8_LAS pg8::bf16_t*)(lds + SC_QH + (j + 1) * SC_RS + ch * 2) = (pg8::bf16_t)(pq >> 16);
                *(PG8_LAS pg8::bf16_t*)(lds + SC_KH + j * SC_RS + ch * 2) = (pg8::bf16_t)(pkk & 0xffffu); *(PG8_LAS pg8::bf16_t*)(lds + SC_KH + (j + 1) * SC_RS + ch * 2) = (pg8::bf16_t)(pkk >> 16);
            }
        }
        __syncthreads();
        float lfn[16]; unsigned vrn[16], qrn[16];
        { const int cn = c + 1 < nch ? c + 1 : c; SCAN_LOADS(cn, lfn, vrn, qrn); }
        pg8::bf16x8 vb[2];
#pragma unroll
        for (int ks = 0; ks < 2; ++ks) vb[ks] = *(const PG8_LAS pg8::bf16x8*)(lds + SC_VT + (16 * w + r) * SC_RS64 + (32 * ks + 8 * quad) * 2);
        pg8::f32x4 oacc[4];
        if (OUT) {
            for (int tile = w; tile < 10; tile += 8) {
                const int Jt = (tile < 1) ? 0 : (tile < 3 ? 1 : (tile < 6 ? 2 : 3)), Js = tile - ((Jt * (Jt + 1)) >> 1);
                pg8::f32x4 a = (pg8::f32x4){0.f, 0.f, 0.f, 0.f};
#pragma unroll
                for (int ks = 0; ks < 4; ++ks) {
                    const pg8::bf16x8 ka = *(const PG8_LAS pg8::bf16x8*)(lds + SC_KH + (16 * Js + r) * SC_RS + (32 * ks + 8 * quad) * 2);
                    const pg8::bf16x8 qb = *(const PG8_LAS pg8::bf16x8*)(lds + SC_QH + (16 * Jt + r) * SC_RS + (32 * ks + 8 * quad) * 2);
                    a = __builtin_amdgcn_mfma_f32_16x16x32_bf16(ka, qb, a, 0, 0, 0);
                }
                if (Jt == Js) {
#pragma unroll
                    for (int rr = 0; rr < 4; ++rr) a[rr] = (4 * quad + rr <= r) ? a[rr] : 0.f;
                }
                u32x2_t pa; pa.x = pg8::cvt_pk_bf16(a[0], a[1]); pa.y = pg8::cvt_pk_bf16(a[2], a[3]);
                *(PG8_LAS u32x2_t*)(lds + SC_A + (16 * Jt + r) * SC_RS64 + (16 * Js + 4 * quad) * 2) = pa;
            }
#pragma unroll
            for (int it = 0; it < 4; ++it) oacc[it] = (pg8::f32x4){0.f, 0.f, 0.f, 0.f};
#pragma unroll
            for (int s2 = 0; s2 < 4; ++s2) {
                union { unsigned u[4]; pg8::bf16x8 v; } sb;
                sb.u[0] = pg8::cvt_pk_bf16(S[2 * s2][0], S[2 * s2][1]); sb.u[1] = pg8::cvt_pk_bf16(S[2 * s2][2], S[2 * s2][3]);
                sb.u[2] = pg8::cvt_pk_bf16(S[2 * s2 + 1][0], S[2 * s2 + 1][1]); sb.u[3] = pg8::cvt_pk_bf16(S[2 * s2 + 1][2], S[2 * s2 + 1][3]);
#pragma unroll
                for (int it = 0; it < 4; ++it) {
                    union { u32x2_t h[2]; pg8::bf16x8 v; } qa;
                    qa.h[0] = *(const PG8_LAS u32x2_t*)(lds + SC_QH + (16 * it + r) * SC_RS + (32 * s2 + 4 * quad) * 2);
                    qa.h[1] = *(const PG8_LAS u32x2_t*)(lds + SC_QH + (16 * it + r) * SC_RS + (32 * s2 + 16 + 4 * quad) * 2);
                    oacc[it] = __builtin_amdgcn_mfma_f32_16x16x32_bf16(qa.v, sb.v, oacc[it], 0, 0, 0);
                }
            }
            __syncthreads();
#pragma unroll
            for (int it = 0; it < 4; ++it)
#pragma unroll
                for (int ks = 0; ks < 2; ++ks) {
                    if (ks == 1 && it < 2) continue;
                    const pg8::bf16x8 aa = *(const PG8_LAS pg8::bf16x8*)(lds + SC_A + (16 * it + r) * SC_RS64 + (32 * ks + 8 * quad) * 2);
                    oacc[it] = __builtin_amdgcn_mfma_f32_16x16x32_bf16(aa, vb[ks], oacc[it], 0, 0, 0);
                }
#pragma unroll
            for (int it = 0; it < 4; ++it)
#pragma unroll
                for (int rr = 0; rr < 4; rr += 2) { const int pos = pos0 + 64 * c + 16 * it + 4 * quad + rr; const int t = dir ? L_ - 1 - pos : pos, t1 = dir ? t - 1 : t + 1;
                    const unsigned po = pg8::cvt_pk_bf16(oacc[it][rr], oacc[it][rr + 1]);
                    O[(size_t)(b * L_ + t) * 512 + h * 128 + 16 * w + r] = (pg8::bf16_t)(po & 0xffffu); O[(size_t)(b * L_ + t1) * 512 + h * 128 + 16 * w + r] = (pg8::bf16_t)(po >> 16); }
        }
#pragma unroll
        for (int t = 0; t < 8; ++t) { const pg8::f32x4 gx = *(const PG8_LAS pg8::f32x4*)(lds + SC_GX + (16 * t + 4 * quad) * 4); S[t] = S[t] * gx; }
#pragma unroll
        for (int t = 0; t < 8; ++t)
#pragma unroll
            for (int ks = 0; ks < 2; ++ks) {
                const pg8::bf16x8 ka = *(const PG8_LAS pg8::bf16x8*)(lds + SC_KT + (16 * t + r) * SC_RS64 + (32 * ks + 8 * quad) * 2);
                S[t] = __builtin_amdgcn_mfma_f32_16x16x32_bf16(ka, vb[ks], S[t], 0, 0, 0);
            }
        { float run = 0.f;
#pragma unroll
          for (int ii = 0; ii < 16; ++ii) { run += lfn[ii]; cs[ii] = run; lf[ii] = 1.f - __builtin_amdgcn_exp2f(lfn[ii]); }
          T[J * 128 + ch] = run; }
        __syncthreads();
#pragma unroll
        for (int ii = 0; ii < 16; ++ii) { vr[ii] = vrn[ii]; if (OUT) qr[ii] = qrn[ii]; }
    }
#undef SCAN_LOADS
}
__device__ void st_scan1(KP p, PG8_LAS unsigned char* lds, int bid, int nb) {
    const int tidx_ = ltid();
    unsigned char* P = p->ws; float* USEG = (float*)(p->ws + RC_USEG); float* GSEG = (float*)(p->ws + RC_GSEG);
    const int tid = tidx_, lane = tid & 63, w = tid >> 6;
    for (int task = bid; task < 320; task += nb) {
        const bool ctx = task >= 256; const int chain = ctx ? (task - 256) >> 2 : task >> 4, seg = ctx ? (task & 3) : (task & 15), dir = chain >> 3, b = (chain >> 2) & 1, h = chain & 3;
        pg8::f32x4 S[8]; float glog = 0.f;
#pragma unroll
        for (int t = 0; t < 8; ++t) S[t] = (pg8::f32x4){0.f, 0.f, 0.f, 0.f};
        if (ctx) scan_task<false>(P, lds, dir, b, h, true, 64 * seg, 1, S, glog, nullptr);
        else scan_task<true>(P, lds, dir, b, h, false, 512 * seg, 8, S, glog, (pg8::bf16_t*)(p->ws + (dir ? RC_OB : RC_OF)));
#pragma unroll
        for (int t = 0; t < 8; ++t)
#pragma unroll
            for (int rr = 0; rr < 4; ++rr) USEG[((size_t)(task * 8 + w) * 32 + t * 4 + rr) * 64 + lane] = S[t][rr];
        if (tid < 128) GSEG[task * 128 + tid] = glog;
    }
}
__device__ void st_scan2(KP p, int bid, int nb) {
    const int tidx_ = ltid();
    typedef float f2_t __attribute__((ext_vector_type(2)));
    const float* USEG = (const float*)(p->ws + RC_USEG); const float* GSEG = (const float*)(p->ws + RC_GSEG); pg8::bf16_t* SST16 = (pg8::bf16_t*)(p->ws + RC_SST);
    for (int i = bid * 512 + tidx_; i < 16 * 8192; i += nb * 512) {
        const int chain = i >> 13, idx = (i & 8191) * 2, reg = (idx >> 6) & 31, ln = idx & 63, d = 16 * (reg >> 2) + 4 * (ln >> 4) + (reg & 3);
        float gq[19]; f2_t uq[19];
#pragma unroll
        for (int j = 0; j < 4; ++j) { gq[j] = GSEG[(256 + chain * 4 + j) * 128 + d]; uq[j] = *(const f2_t*)(USEG + (size_t)(256 + chain * 4 + j) * 16384 + idx); }
#pragma unroll
        for (int sg = 0; sg < 15; ++sg) { gq[4 + sg] = GSEG[(chain * 16 + sg) * 128 + d]; uq[4 + sg] = *(const f2_t*)(USEG + (size_t)(chain * 16 + sg) * 16384 + idx); }
        f2_t S = {0.f, 0.f};
#pragma unroll
        for (int j = 0; j < 4; ++j) S = S * __builtin_amdgcn_exp2f(gq[j]) + uq[j];
        *(unsigned*)(SST16 + (size_t)(chain * 16) * 16384 + idx) = pg8::cvt_pk_bf16(S.x, S.y);
#pragma unroll
        for (int sg = 0; sg < 15; ++sg) { S = S * __builtin_amdgcn_exp2f(gq[4 + sg]) + uq[4 + sg]; *(unsigned*)(SST16 + (size_t)(chain * 16 + sg + 1) * 16384 + idx) = pg8::cvt_pk_bf16(S.x, S.y); }
    }
}
constexpr int CR_RS = 132, CR_QRS = 272, CR_TILE = 2 * 64 * CR_QRS;
__device__ void st_corr_rec(KP p, PG8_LAS unsigned char* lds, int bid, int nb) {
    const int tidx_ = ltid();
    const pg8::bf16_t* SST16 = (const pg8::bf16_t*)(p->ws + RC_SST); const pg8::bf16_t* QT = (const pg8::bf16_t*)(p->ws + RC_PF);
    const pg8::bf16_t* PG = (const pg8::bf16_t*)(p->ws + RC_PG); const pg8::bf16_t* OF = (const pg8::bf16_t*)(p->ws + RC_OF); const pg8::bf16_t* OB = (const pg8::bf16_t*)(p->ws + RC_OB); pg8::bf16_t* MIX = (pg8::bf16_t*)(p->ws + RC_MIX);
    PG8_LAS float* tile = (PG8_LAS float*)(lds + CR_TILE);
    const int tid = tidx_, lane = tid & 63, w = tid >> 6, r = lane & 15, quad = lane >> 4;
    const int tk = tid >> 3, e0 = (tid & 7) * 16;
    const int qrow = tid >> 4, qseg = tid & 15;
    for (int item = bid; item < 256; item += nb) {
        const int half = item & 1, sg = (item >> 1) & 15, h = (item >> 5) & 3, b = item >> 7;
        const int rowi = b * L_ + 512 * sg + 256 * half;
        pg8::u32x4 qn[4], en[6];
#define CR_NT(ptr) __builtin_nontemporal_load((const pg8::u32x4*)(ptr))
#define CR_LOADS(c) do { const int row0_ = rowi + 64 * (c); \
            _Pragma("unroll") for (int k = 0; k < 4; ++k) qn[k] = CR_NT(QT + (size_t)(row0_ + qrow + 32 * (k & 1)) * 1024 + (k >> 1) * 512 + h * 128 + qseg * 8); \
            const size_t ro_ = (size_t)(row0_ + tk) * 512 + h * 128 + e0; \
            en[0] = CR_NT(OF + ro_); en[1] = CR_NT(OF + ro_ + 8); en[2] = CR_NT(OB + ro_); en[3] = CR_NT(OB + ro_ + 8); \
            en[4] = CR_NT(PG + ro_); en[5] = CR_NT(PG + ro_ + 8); } while (0)
        CR_LOADS(0);
        pg8::bf16x8 sb[2][4];
#pragma unroll
        for (int dir = 0; dir < 2; ++dir) {
            const int task = (dir * 8 + b * 4 + h) * 16 + (dir ? 15 - sg : sg);
            const pg8::bf16_t* Sp = SST16 + ((size_t)(task * 8 + w) * 32) * 64 + lane;
#pragma unroll
            for (int s2 = 0; s2 < 4; ++s2) {
                union { unsigned u[4]; pg8::bf16x8 v; } cv;
#pragma unroll
                for (int k2 = 0; k2 < 4; ++k2) cv.u[k2] = (unsigned)Sp[(8 * s2 + 2 * k2) * 64] | ((unsigned)Sp[(8 * s2 + 2 * k2 + 1) * 64] << 16);
                sb[dir][s2] = cv.v;
            }
        }
        const pg8::f32x4 gr0 = *(const pg8::f32x4*)(p->g_rec + h * 128 + e0), gr1 = *(const pg8::f32x4*)(p->g_rec + h * 128 + e0 + 4), gr2 = *(const pg8::f32x4*)(p->g_rec + h * 128 + e0 + 8), gr3 = *(const pg8::f32x4*)(p->g_rec + h * 128 + e0 + 12);
        for (int c = 0; c < 4; ++c) {
            const int row0 = rowi + 64 * c;
#pragma unroll
            for (int k = 0; k < 4; ++k) *(PG8_LAS pg8::u32x4*)(lds + ((k >> 1) * 64 + qrow + 32 * (k & 1)) * CR_QRS + qseg * 16) = qn[k];
            const pg8::u32x4 f0 = en[0], f1 = en[1], b0 = en[2], b1 = en[3], g0 = en[4], g1 = en[5];
            __syncthreads();
            { const int cn = c + 1 < 4 ? c + 1 : c; CR_LOADS(cn); }
            pg8::f32x4 oacc[4];
#pragma unroll
            for (int it = 0; it < 4; ++it) oacc[it] = (pg8::f32x4){0.f, 0.f, 0.f, 0.f};
#pragma unroll
            for (int dir = 0; dir < 2; ++dir)
#pragma unroll
                for (int s2 = 0; s2 < 4; ++s2)
#pragma unroll
                    for (int it = 0; it < 4; ++it) {
                        const PG8_LAS unsigned char* qp = lds + (dir * 64 + 16 * it + r) * CR_QRS + (32 * s2 + 4 * quad) * 2;
                        union { u32x2_t hh[2]; pg8::bf16x8 v; } qa;
                        qa.hh[0] = *(const PG8_LAS u32x2_t*)qp; qa.hh[1] = *(const PG8_LAS u32x2_t*)(qp + 32);
                        oacc[it] = __builtin_amdgcn_mfma_f32_16x16x32_bf16(qa.v, sb[dir][s2], oacc[it], 0, 0, 0);
                    }
#pragma unroll
            for (int it = 0; it < 4; ++it)
#pragma unroll
                for (int rr = 0; rr < 4; ++rr) tile[(16 * it + 4 * quad + rr) * CR_RS + 16 * w + r] = oacc[it][rr];
            __syncthreads();
            float a[16];
#pragma unroll
            for (int q4 = 0; q4 < 4; ++q4) { const pg8::f32x4 t4 = *(const PG8_LAS pg8::f32x4*)(tile + tk * CR_RS + e0 + 4 * q4); a[4 * q4] = t4[0]; a[4 * q4 + 1] = t4[1]; a[4 * q4 + 2] = t4[2]; a[4 * q4 + 3] = t4[3]; }
            float gs[16];
#pragma unroll
            for (int j = 0; j < 4; ++j) {
                a[2 * j] += __uint_as_float(f0[j] << 16) + __uint_as_float(b0[j] << 16); a[2 * j + 1] += __uint_as_float(f0[j] & 0xffff0000u) + __uint_as_float(b0[j] & 0xffff0000u);
                a[8 + 2 * j] += __uint_as_float(f1[j] << 16) + __uint_as_float(b1[j] << 16); a[8 + 2 * j + 1] += __uint_as_float(f1[j] & 0xffff0000u) + __uint_as_float(b1[j] & 0xffff0000u);
                gs[2 * j] = __uint_as_float(g0[j] << 16); gs[2 * j + 1] = __uint_as_float(g0[j] & 0xffff0000u); gs[8 + 2 * j] = __uint_as_float(g1[j] << 16); gs[8 + 2 * j + 1] = __uint_as_float(g1[j] & 0xffff0000u);
            }
            float ss = 0.f;
#pragma unroll
            for (int j = 0; j < 16; ++j) ss += a[j] * a[j];
            ss += __shfl_xor(ss, 1); ss += __shfl_xor(ss, 2); ss += __shfl_xor(ss, 4);
            const float rstd = rsqrtf(ss * (1.0f / 128.0f) + EPS_);
            float y[16];
#pragma unroll
            for (int j = 0; j < 16; ++j) { const float wgt = (j < 4) ? gr0[j & 3] : (j < 8 ? gr1[j & 3] : (j < 12 ? gr2[j & 3] : gr3[j & 3])); y[j] = a[j] * rstd * wgt * siluf(gs[j]); }
            pg8::u32x4 o0, o1;
            o0.x = pg8::cvt_pk_bf16(y[0], y[1]); o0.y = pg8::cvt_pk_bf16(y[2], y[3]); o0.z = pg8::cvt_pk_bf16(y[4], y[5]); o0.w = pg8::cvt_pk_bf16(y[6], y[7]);
            o1.x = pg8::cvt_pk_bf16(y[8], y[9]); o1.y = pg8::cvt_pk_bf16(y[10], y[11]); o1.z = pg8::cvt_pk_bf16(y[12], y[13]); o1.w = pg8::cvt_pk_bf16(y[14], y[15]);
            pg8::bf16_t* mo = MIX + (size_t)(row0 + tk) * D_ + 512 + h * 128 + e0;
            *(pg8::u32x4*)mo = o0; *(pg8::u32x4*)(mo + 8) = o1;
        }
        __syncthreads();
#undef CR_LOADS
#undef CR_NT
    }
}

__device__ void st_prep(KP p, PG8_LAS float* red, int bid, int nb) {
    const int tidx_ = ltid();
    float* MODP = (float*)(p->ws + WS_MODP); float* LB = (float*)(p->ws + WS_LB); float* CS = (float*)(p->ws + WS_COS);
    const int tid = tidx_, lane = tid & 63, wv = tid >> 6, gt = bid * 512 + tid, nt = nb * 512;
    for (int blk = bid; blk < 192; blk += nb) {
        const int cc = blk % 24, kg = blk / 24, k0 = kg * 128 + wv * 16;
        float4 wv4[16];
#pragma unroll
        for (int i = 0; i < 16; ++i) { const pg8::f32x4 t4 = __builtin_nontemporal_load((const pg8::f32x4*)(p->w_ada + (size_t)(k0 + i) * 6144 + cc * 256 + lane * 4)); wv4[i] = make_float4(t4[0], t4[1], t4[2], t4[3]); }
        float acc[3][4];
#pragma unroll
        for (int r = 0; r < 3; ++r)
#pragma unroll
            for (int q = 0; q < 4; ++q) acc[r][q] = 0.f;
#pragma unroll
        for (int i = 0; i < 16; ++i) {
            const float s0 = siluf(p->c[k0 + i]), s1 = siluf(p->c[D_ + k0 + i]), s2 = siluf(p->c_ctx[k0 + i]);
            acc[0][0] = fmaf(s0, wv4[i].x, acc[0][0]); acc[0][1] = fmaf(s0, wv4[i].y, acc[0][1]); acc[0][2] = fmaf(s0, wv4[i].z, acc[0][2]); acc[0][3] = fmaf(s0, wv4[i].w, acc[0][3]);
            acc[1][0] = fmaf(s1, wv4[i].x, acc[1][0]); acc[1][1] = fmaf(s1, wv4[i].y, acc[1][1]); acc[1][2] = fmaf(s1, wv4[i].z, acc[1][2]); acc[1][3] = fmaf(s1, wv4[i].w, acc[1][3]);
            acc[2][0] = fmaf(s2, wv4[i].x, acc[2][0]); acc[2][1] = fmaf(s2, wv4[i].y, acc[2][1]); acc[2][2] = fmaf(s2, wv4[i].z, acc[2][2]); acc[2][3] = fmaf(s2, wv4[i].w, acc[2][3]);
        }
        __syncthreads();
#pragma unroll
        for (int r = 0; r < 3; ++r) *(PG8_LAS pg8::f32x4*)(red + (wv * 3 + r) * 256 + lane * 4) = (pg8::f32x4){acc[r][0], acc[r][1], acc[r][2], acc[r][3]};
        __syncthreads();
        for (int e = tid; e < 768; e += 512) { float sm = 0.f;
#pragma unroll
            for (int w2 = 0; w2 < 8; ++w2) sm += red[w2 * 768 + e];
            MODP[(size_t)(kg * 3 + e / 256) * 6144 + cc * 256 + (e & 255)] = sm; }
    }
    for (int i = gt; i < 1024; i += nt) { const float l0 = p->lb_logits[i], l1 = p->lb_logits[1024 + i]; LB[i] = 1.0f / (1.0f + expf(l1 - l0)); }
    for (int i = gt; i < 8192; i += nt) CS[i] = cospif((float)i / 4096.0f);
}
__device__ void st_hcat(KP p, PG8_LAS float* tab, int bid, int nb) {
    const int tidx_ = ltid();
    const float* MODP = (const float*)(p->ws + WS_MODP); float* MOD = (float*)(p->ws + WS_MOD); pg8::bf16_t* H = (pg8::bf16_t*)(p->ws + RC_HCAT);
    const int tid = tidx_, lane = tid & 63, wv = tid >> 6;
    for (int i = bid * 512 + tid; i < 3 * 6144; i += nb * 512) { float sm = p->b_ada[i % 6144];
#pragma unroll
        for (int kg = 0; kg < 8; ++kg) sm += MODP[(size_t)kg * 18432 + i];
        MOD[i] = sm; }
    for (int grp = bid; grp < 256; grp += nb) {
        const int mr = grp >> 7, row0 = grp * 64;
        pg8::f32x4 v[2][4][4];
#define HCAT_LOAD(rb) do { _Pragma("unroll") for (int rr = 0; rr < 4; ++rr) { const float* src = p->x + (size_t)(row0 + wv * 8 + (rb) * 4 + rr) * D_; \
            _Pragma("unroll") for (int j = 0; j < 4; ++j) v[rb][rr][j] = __builtin_nontemporal_load((const pg8::f32x4*)(src + j * 256 + lane * 4)); } } while (0)
        HCAT_LOAD(0); HCAT_LOAD(1);
        pg8::f32x4 c4[4];
        { const float* csrc = p->ctx + (size_t)(2 * grp + (wv & 1)) * D_;
#pragma unroll
          for (int j = 0; j < 4; ++j) c4[j] = *(const pg8::f32x4*)(csrc + j * 256 + lane * 4); }
        __syncthreads();
        for (int j = tid; j < 4096; j += 512) { const int jj = j & 2047, m2 = j < 2048 ? mr : 2; float sm = p->b_ada[jj];
#pragma unroll
            for (int kg = 0; kg < 8; ++kg) sm += MODP[(size_t)(kg * 3 + m2) * 6144 + jj];
            tab[j] = sm; }
        __syncthreads();
#pragma unroll
        for (int rb = 0; rb < 2; ++rb) {
            float rstd[4];
#pragma unroll
            for (int rr = 0; rr < 4; ++rr) { float ss = 0.f;
#pragma unroll
                for (int j = 0; j < 4; ++j) ss += v[rb][rr][j][0] * v[rb][rr][j][0] + v[rb][rr][j][1] * v[rb][rr][j][1] + v[rb][rr][j][2] * v[rb][rr][j][2] + v[rb][rr][j][3] * v[rb][rr][j][3];
                rstd[rr] = rsqrtf(wave_sum(ss) * (1.0f / D_) + EPS_); }
#pragma unroll
            for (int j = 0; j < 4; ++j) {
                const int col = j * 256 + lane * 4; const pg8::f32x4 g = *(const pg8::f32x4*)(p->g_mix + col), sh = *(const PG8_LAS pg8::f32x4*)(tab + col), sc = *(const PG8_LAS pg8::f32x4*)(tab + 1024 + col);
                const pg8::f32x4 gs = g * (sc + 1.0f);
#pragma unroll
                for (int rr = 0; rr < 4; ++rr) { const int row = row0 + wv * 8 + rb * 4 + rr; const pg8::f32x4 o = v[rb][rr][j] * rstd[rr] * gs + sh;
                    u32x2_t w; w.x = pg8::cvt_pk_bf16(o[0], o[1]); w.y = pg8::cvt_pk_bf16(o[2], o[3]); *(u32x2_t*)(H + (size_t)row * D_ + col) = w; }
            }
        }
#undef HCAT_LOAD
        if (wv < 2) {
            const int crow = 2 * grp + wv; float ss = 0.f;
#pragma unroll
            for (int j = 0; j < 4; ++j) ss += c4[j][0] * c4[j][0] + c4[j][1] * c4[j][1] + c4[j][2] * c4[j][2] + c4[j][3] * c4[j][3];
            const float rs = rsqrtf(wave_sum(ss) * (1.0f / D_) + EPS_);
#pragma unroll
            for (int j = 0; j < 4; ++j) { const int col = j * 256 + lane * 4; const pg8::f32x4 g = *(const pg8::f32x4*)(p->g_mix + col), sh = *(const PG8_LAS pg8::f32x4*)(tab + 2048 + col), sc = *(const PG8_LAS pg8::f32x4*)(tab + 3072 + col);
                const pg8::f32x4 o = c4[j] * rs * (g * (sc + 1.0f)) + sh; u32x2_t w; w.x = pg8::cvt_pk_bf16(o[0], o[1]); w.y = pg8::cvt_pk_bf16(o[2], o[3]); *(u32x2_t*)(H + (size_t)(RL_ + crow) * D_ + col) = w; }
        }
    }
}
constexpr int RT_RUN = 32 * 64 + 16, RT_BIAS = 8 * RT_RUN, RT_RS = RT_BIAS + 16, RT_EX = RT_RS + 64, RT_GS = RT_EX + 1024;
__device__ void st_router(KP p, PG8_LAS float* wl, int bid, int nb) {
    const int tidx_ = ltid();
    const float* MOD = (const float*)(p->ws + WS_MOD); const _Float16* X1 = (const _Float16*)(p->ws + RC_X1); unsigned char* H2B = p->ws + RC_H2B; float* AFF = (float*)(p->ws + WS_AFF);
    const int tid = tidx_, lane = tid & 63, wv = tid >> 6;
    for (int grp = bid; grp < RL_ / 64; grp += nb) {
        const int bb = grp >> 7; const float* md = MOD + bb * 6144;
        __syncthreads();
        for (int k = tid; k < 1024; k += 512) { wl[RT_GS + k] = p->g_ffn[k] * (md[4096 + k] + 1.0f); wl[RT_GS + 1024 + k] = md[3072 + k]; }
        __syncthreads();
        {
            const int e = tid & 15; float bp = 0.f;
#pragma unroll 1
            for (int hb = 0; hb < 2; ++hb) {
                float wreg[16];
#pragma unroll
                for (int it = 0; it < 16; ++it) wreg[it] = p->w_router[tid + 512 * (16 * hb + it)];
#pragma unroll
                for (int it = 0; it < 16; ++it) { const int k = (tid >> 4) + 32 * (16 * hb + it); const float w = wreg[it];
                    bp = fmaf(wl[RT_GS + 1024 + k], w, bp);
                    const int kh = k >> 9, q = (k >> 7) & 3, i = k & 127;
                    wl[(kh * 4 + q) * RT_RUN + (i >> 2) * 64 + e * 4 + (i & 3)] = w * wl[RT_GS + k]; }
            }
            wl[RT_EX + tid] = bp;
        }
        __syncthreads();
        if (tid < 16) { float sm = 0.f;
#pragma unroll 8
            for (int j = 0; j < 32; ++j) sm += wl[RT_EX + j * 16 + tid];
            wl[RT_BIAS + tid] = sm; }
        pg8::f32x4 gsv[4], shv[4];
#pragma unroll
        for (int j = 0; j < 4; ++j) { gsv[j] = *(const PG8_LAS pg8::f32x4*)(wl + RT_GS + j * 256 + lane * 4); shv[j] = *(const PG8_LAS pg8::f32x4*)(wl + RT_GS + 1024 + j * 256 + lane * 4); }
        h4v_t ra4[4], rb4[4];
#pragma unroll
        for (int j = 0; j < 4; ++j) { ra4[j] = *(const h4v_t*)(X1 + (size_t)(grp * 64 + wv * 8) * D_ + j * 256 + lane * 4); rb4[j] = *(const h4v_t*)(X1 + (size_t)(grp * 64 + wv * 8 + 1) * D_ + j * 256 + lane * 4); }
#pragma unroll 1
        for (int pr = 0; pr < 4; ++pr) {
            const int rowA = grp * 64 + wv * 8 + pr * 2, rowB = rowA + 1;
            pg8::f32x4 xa[4], xb[4]; float sa = 0.f, sb = 0.f;
#pragma unroll
            for (int j = 0; j < 4; ++j) { const h4v_t ha4 = ra4[j], hb4 = rb4[j];
                xa[j] = (pg8::f32x4){(float)ha4[0], (float)ha4[1], (float)ha4[2], (float)ha4[3]}; xb[j] = (pg8::f32x4){(float)hb4[0], (float)hb4[1], (float)hb4[2], (float)hb4[3]}; }
            { const int rowN = grp * 64 + wv * 8 + (pr < 3 ? pr + 1 : pr) * 2;
#pragma unroll
              for (int j = 0; j < 4; ++j) { ra4[j] = *(const h4v_t*)(X1 + (size_t)rowN * D_ + j * 256 + lane * 4); rb4[j] = *(const h4v_t*)(X1 + (size_t)(rowN + 1) * D_ + j * 256 + lane * 4); } }
#pragma unroll
            for (int j = 0; j < 4; ++j) { sa += xa[j][0] * xa[j][0] + xa[j][1] * xa[j][1] + xa[j][2] * xa[j][2] + xa[j][3] * xa[j][3]; sb += xb[j][0] * xb[j][0] + xb[j][1] * xb[j][1] + xb[j][2] * xb[j][2] + xb[j][3] * xb[j][3]; }
            sa = wave_sum(sa); sb = wave_sum(sb);
            const float ra = rsqrtf(sa * (1.0f / D_) + EPS_), rb = rsqrtf(sb * (1.0f / D_) + EPS_);
            if (lane == 0) { wl[RT_RS + wv * 8 + pr * 2] = ra; wl[RT_RS + wv * 8 + pr * 2 + 1] = rb; }
#pragma unroll
            for (int j = 0; j < 4; ++j) {
                const int col = j * 256 + lane * 4; const pg8::f32x4 ha = xa[j] * ra * gsv[j] + shv[j], hb = xb[j] * rb * gsv[j] + shv[j];
                *(unsigned*)(H2B + (size_t)rowA * D_ + col) = pk4_fp8(__builtin_amdgcn_fmed3f(ha[0] * 4.0f, -448.f, 448.f), __builtin_amdgcn_fmed3f(ha[1] * 4.0f, -448.f, 448.f), __builtin_amdgcn_fmed3f(ha[2] * 4.0f, -448.f, 448.f), __builtin_amdgcn_fmed3f(ha[3] * 4.0f, -448.f, 448.f));
                *(unsigned*)(H2B + (size_t)rowB * D_ + col) = pk4_fp8(__builtin_amdgcn_fmed3f(hb[0] * 4.0f, -448.f, 448.f), __builtin_amdgcn_fmed3f(hb[1] * 4.0f, -448.f, 448.f), __builtin_amdgcn_fmed3f(hb[2] * 4.0f, -448.f, 448.f), __builtin_amdgcn_fmed3f(hb[3] * 4.0f, -448.f, 448.f));
            }
        }
        const int t = wv >> 1, kh = wv & 1, r = lane & 15, q = lane >> 4;
        pg8::f32x4 acc = (pg8::f32x4){0.f, 0.f, 0.f, 0.f};
        { const _Float16* xr = X1 + (size_t)(grp * 64 + 16 * t + r) * D_ + kh * 512 + q * 128;
          const PG8_LAS float* wb = wl + (kh * 4 + q) * RT_RUN + r * 4;
          h8v_t xq[16];
#pragma unroll
          for (int c8 = 0; c8 < 16; ++c8) xq[c8] = *(const h8v_t*)(xr + 8 * c8);
#pragma unroll
          for (int c8 = 0; c8 < 16; ++c8) {
              const h8v_t xh = xq[c8];
              const pg8::f32x4 b0 = *(const PG8_LAS pg8::f32x4*)(wb + (2 * c8) * 64), b1 = *(const PG8_LAS pg8::f32x4*)(wb + (2 * c8 + 1) * 64);
#pragma unroll
              for (int j = 0; j < 4; ++j) acc = __builtin_amdgcn_mfma_f32_16x16x4f32((float)xh[j], b0[j], acc, 0, 0, 0);
#pragma unroll
              for (int j = 0; j < 4; ++j) acc = __builtin_amdgcn_mfma_f32_16x16x4f32((float)xh[4 + j], b1[j], acc, 0, 0, 0);
          } }
        __syncthreads();
        if (kh == 1) *(PG8_LAS pg8::f32x4*)(wl + RT_EX + (t * 64 + lane) * 4) = acc;
        __syncthreads();
        if (kh == 0) {
            const pg8::f32x4 o2 = *(const PG8_LAS pg8::f32x4*)(wl + RT_EX + (t * 64 + lane) * 4); const float bs = wl[RT_BIAS + r];
            pg8::f32x4 lg, mx, sm;
#pragma unroll
            for (int j = 0; j < 4; ++j) { lg[j] = (acc[j] + o2[j]) * wl[RT_RS + 16 * t + 4 * q + j] + bs; mx[j] = lg[j]; }
#pragma unroll
            for (int o = 1; o < 16; o <<= 1)
#pragma unroll
                for (int j = 0; j < 4; ++j) mx[j] = fmaxf(mx[j], __shfl_xor(mx[j], o));
#pragma unroll
            for (int j = 0; j < 4; ++j) { lg[j] = expf(lg[j] - mx[j]); sm[j] = lg[j]; }
#pragma unroll
            for (int o = 1; o < 16; o <<= 1)
#pragma unroll
                for (int j = 0; j < 4; ++j) sm[j] += __shfl_xor(sm[j], o);
            pg8::f32x4 af;
#pragma unroll
            for (int j = 0; j < 4; ++j) af[j] = lg[j] / sm[j];
            *(pg8::f32x4*)(AFF + (size_t)(bb * 16 + r) * L_ + ((grp * 64 + 16 * t + 4 * q) & 8191)) = af;
        }
    }
}
__device__ void st_topk(KP p, PG8_LAS int* sh, int bid, int nb) {
    const int tidx_ = ltid();
    const float* AFF = (const float*)(p->ws + WS_AFF); int* IDX = (int*)(p->ws + WS_IDX); float* GATE = (float*)(p->ws + WS_GATE); int* SLOT = (int*)(p->ws + WS_SLOT); float* GATER = (float*)(p->ws + WS_GATER);
    const int tid = tidx_, lane = tid & 63, wv = tid >> 6;
    for (int it = bid; it < 32; it += nb) {
        const int bb = it >> 4, e = it & 15;
        unsigned key[16];
        { const uint4* src = (const uint4*)(AFF + (size_t)(bb * 16 + e) * L_ + tid * 16);
#pragma unroll
          for (int q = 0; q < 4; ++q) { const uint4 v = src[q]; key[4 * q] = v.x; key[4 * q + 1] = v.y; key[4 * q + 2] = v.z; key[4 * q + 3] = v.w; } }
        unsigned prefix = 0u, mask = 0u; int need = CAP_;
        for (int pass = 0; pass < 4; ++pass) {
            const int shift = 24 - 8 * pass;
            __syncthreads();
            if (tid < 256) sh[tid] = 0;
            __syncthreads();
#pragma unroll
            for (int i = 0; i < 16; ++i) if ((key[i] & mask) == prefix) __hip_atomic_fetch_add(sh + ((key[i] >> shift) & 255), 1, __ATOMIC_RELAXED, __HIP_MEMORY_SCOPE_WORKGROUP);
            __syncthreads();
            if (wv == 0) {
                int h4[4]; int tot = 0;
#pragma unroll
                for (int q = 0; q < 4; ++q) { h4[q] = sh[4 * lane + q]; tot += h4[q]; }
                int incl = tot;
#pragma unroll
                for (int o = 1; o < 64; o <<= 1) { const int v = __shfl_down(incl, o); if (lane + o < 64) incl += v; }
                int above = incl - tot;
#pragma unroll
                for (int q = 3; q >= 0; --q) { if (above < need && above + h4[q] >= need) { sh[256] = 4 * lane + q; sh[257] = need - above; } above += h4[q]; }
            }
            __syncthreads();
            prefix |= (unsigned)sh[256] << shift; mask |= 255u << shift; need = sh[257];
        }
        int cg = 0, ce = 0;
#pragma unroll
        for (int i = 0; i < 16; ++i) { cg += key[i] > prefix; ce += key[i] == prefix; }
        int v = cg | (ce << 16), incl = v;
#pragma unroll
        for (int o = 1; o < 64; o <<= 1) { const int u = __shfl_up(incl, o); if (lane >= o) incl += u; }
        __syncthreads();
        if (lane == 63) sh[260 + wv] = incl;
        __syncthreads();
        int base = 0;
#pragma unroll
        for (int w2 = 0; w2 < 8; ++w2) if (w2 < wv) base += sh[260 + w2];
        const int excl = base + incl - v; int ng = excl & 0xffff, ne = excl >> 16;
#pragma unroll
        for (int i = 0; i < 16; ++i) {
            const int t = tid * 16 + i; const bool g = key[i] > prefix, q = key[i] == prefix, take = g || (q && ne < need);
            const int slot = ng + (ne < need ? ne : need);
            if (take) { const float a = __uint_as_float(key[i]); IDX[(bb * 16 + e) * 1024 + slot] = t; GATE[(bb * 16 + e) * 1024 + slot] = a; GATER[e * 2048 + bb * 1024 + slot] = a; }
            SLOT[(size_t)(bb * L_ + t) * 16 + e] = take ? slot : -1;
            ng += g; ne += q;
        }
    }
}
__device__ void st_final(KP p, int bid, int nb) {
    const int tidx_ = ltid();
    const float* MOD = (const float*)(p->ws + WS_MOD); const _Float16* X1 = (const _Float16*)(p->ws + RC_X1); const pg8::bf16_t* YE = (const pg8::bf16_t*)(p->ws + WS_YE); const int* SLOT = (const int*)(p->ws + WS_SLOT);
    const int lane = tidx_ & 63, gw = bid * 8 + (tidx_ >> 6), nw = nb * 8;
    for (int row0 = gw * 2; row0 < RL_; row0 += nw * 2) {
        const int bb = row0 >> 13; const float* md = MOD + bb * 6144;
        const int sl = SLOT[(size_t)row0 * 16 + (lane & 31)];
        pg8::f32x4 xv[2][4];
#pragma unroll
        for (int r = 0; r < 2; ++r)
#pragma unroll
            for (int jh = 0; jh < 2; ++jh) { const h8v_t h8 = *(const h8v_t*)(X1 + (size_t)(row0 + r) * D_ + jh * 512 + lane * 8);
                xv[r][2 * jh] = (pg8::f32x4){(float)h8[0], (float)h8[1], (float)h8[2], (float)h8[3]}; xv[r][2 * jh + 1] = (pg8::f32x4){(float)h8[4], (float)h8[5], (float)h8[6], (float)h8[7]}; }
        const unsigned long long bal = __ballot(sl >= 0);
        pg8::f32x4 acc[2][4];
#pragma unroll
        for (int r = 0; r < 2; ++r) {
#pragma unroll
            for (int j = 0; j < 4; ++j) acc[r][j] = (pg8::f32x4){0.f, 0.f, 0.f, 0.f};
            unsigned m = (unsigned)(bal >> (16 * r)) & 0xffffu;
            while (m) {
                const int e = __builtin_ctz(m); m &= m - 1;
                const int c = __builtin_amdgcn_readlane(sl, 16 * r + e);
                const pg8::bf16_t* yr = YE + (size_t)(e * 2048 + bb * 1024 + c) * D_ + lane * 8;
#pragma unroll
                for (int jh = 0; jh < 2; ++jh) { const pg8::u32x4 y = *(const pg8::u32x4*)(yr + jh * 512);
                    acc[r][2 * jh][0] += __uint_as_float(y.x << 16); acc[r][2 * jh][1] += __uint_as_float(y.x & 0xffff0000u); acc[r][2 * jh][2] += __uint_as_float(y.y << 16); acc[r][2 * jh][3] += __uint_as_float(y.y & 0xffff0000u);
                    acc[r][2 * jh + 1][0] += __uint_as_float(y.z << 16); acc[r][2 * jh + 1][1] += __uint_as_float(y.z & 0xffff0000u); acc[r][2 * jh + 1][2] += __uint_as_float(y.w << 16); acc[r][2 * jh + 1][3] += __uint_as_float(y.w & 0xffff0000u); }
            }
        }
#pragma unroll
        for (int r = 0; r < 2; ++r) {
            pg8::f32x4 v[4]; float ss = 0.f;
#pragma unroll
            for (int j = 0; j < 4; ++j) { const pg8::f32x4 gt = *(const pg8::f32x4*)(md + 5120 + (j >> 1) * 512 + lane * 8 + (j & 1) * 4); v[j] = xv[r][j] + gt * acc[r][j]; ss += v[j][0] * v[j][0] + v[j][1] * v[j][1] + v[j][2] * v[j][2] + v[j][3] * v[j][3]; }
            ss = wave_sum(ss); const float rstd = rsqrtf(ss * (1.0f / D_) + EPS_);
#pragma unroll
            for (int j = 0; j < 4; ++j) { const int col = (j >> 1) * 512 + lane * 8 + (j & 1) * 4; const pg8::f32x4 g = *(const pg8::f32x4*)(p->g_final + col); *(pg8::f32x4*)(p->out + (size_t)(row0 + r) * D_ + col) = v[j] * rstd * g; }
        }
    }
}

#define XB_TMO      128
#define XB_XCNT(j)  (256  + 64 * (j))
#define XB_XSUB(j)  (1280 + 64 * (j))
#define XB_XGEN(j)  (2304 + 64 * (j))
#define XB_TOP      3328
#define XB_TOPGEN   3392
#define XCD_BAR_WORDS 3456
#define XB_SPIN_CAP (1u << 20)
__device__ __forceinline__ unsigned xb_ld(unsigned* q)              { return __hip_atomic_load(q, __ATOMIC_RELAXED, __HIP_MEMORY_SCOPE_AGENT); }
__device__ __forceinline__ unsigned xb_add(unsigned* q, unsigned v) { return __hip_atomic_fetch_add(q, v, __ATOMIC_RELAXED, __HIP_MEMORY_SCOPE_AGENT); }
__device__ __forceinline__ unsigned xb_xcc_id() { return (unsigned)__builtin_amdgcn_s_getreg((3 << 11) | 20) & 0xFu; }
#define XB_SPIN(cond, bar) do { unsigned _sp = 0; while (cond) { __builtin_amdgcn_s_sleep(1); \
    if ((++_sp & 255u) == 0u) { if (xb_ld(&(bar)[XB_TMO])) break; if (_sp > XB_SPIN_CAP) { atomicAdd(&(bar)[XB_TMO], 1u); break; } } } } while (0)
struct XcdBarrier { unsigned* bar; unsigned x; volatile PG8_LAS unsigned* st; };
__device__ __forceinline__ XcdBarrier xcd_barrier_post(unsigned* bar, volatile PG8_LAS unsigned* st) {
    XcdBarrier b; b.bar = bar; b.x = xb_xcc_id(); b.st = st;
    if (threadIdx.x == 0) (void)xb_add(&bar[XB_XCNT(b.x)], 1u);
    return b;
}
__device__ __forceinline__ void xcd_barrier_complete(unsigned* bar, unsigned x, unsigned& nloc, unsigned& nx) {
    const unsigned G = gridDim.x * gridDim.y * gridDim.z;
    unsigned sum, cnt, mine, sp = 0u;
    for (;;) {
        sum = 0u; cnt = 0u; mine = 0u;
#pragma unroll
        for (unsigned j = 0; j < 16; ++j) { const unsigned c = xb_ld(&bar[XB_XCNT(j)]); sum += c; cnt += (c > 0u) ? 1u : 0u; mine = (j == x) ? c : mine; }
        if (sum == G) break;
        __builtin_amdgcn_s_sleep(1);
        if ((++sp & 255u) == 0u) { if (xb_ld(&bar[XB_TMO])) break; if (sp > XB_SPIN_CAP) { atomicAdd(&bar[XB_TMO], 1u); break; } }
    }
    nloc = mine > 0u ? mine : 1u; nx = cnt > 0u ? cnt : 1u;
}
__device__ __forceinline__ void xcd_barrier(const XcdBarrier& b) {
    asm volatile("s_waitcnt vmcnt(0)" ::: "memory");
    __syncthreads();
    if (threadIdx.x == 0) {
        unsigned* bar = b.bar;
        __builtin_amdgcn_s_waitcnt(0);
        unsigned nloc = b.st[0], nx = b.st[1];
        if (nloc == 0u) { xcd_barrier_complete(bar, b.x, nloc, nx); b.st[0] = nloc; b.st[1] = nx; }
        const unsigned old = xb_add(&bar[XB_XSUB(b.x)], 1u);
        const unsigned gen = old / nloc;
        if (old + 1u == (gen + 1u) * nloc) {
            __builtin_amdgcn_fence(__ATOMIC_RELEASE, "agent");
            asm volatile("s_waitcnt vmcnt(0)" ::: "memory");
            const unsigned og = xb_add(&bar[XB_TOP], 1u);
            const unsigned tg = og / nx;
            if (og + 1u == (tg + 1u) * nx) xb_add(&bar[XB_TOPGEN], 1u);
            else XB_SPIN(xb_ld(&bar[XB_TOPGEN]) == tg, bar);
            __builtin_amdgcn_fence(__ATOMIC_ACQUIRE, "agent");
            xb_add(&bar[XB_XGEN(b.x)], 1u);
            asm volatile("s_waitcnt vmcnt(0)" ::: "memory");
        } else {
            XB_SPIN(xb_ld(&bar[XB_XGEN(b.x)]) == gen, bar);
            __builtin_amdgcn_fence(__ATOMIC_ACQUIRE, "agent");
            asm volatile("s_waitcnt vmcnt(0)" ::: "memory");
        }
    }
    __syncthreads();
}

constexpr int GOFS_OFF = 131072 + 16, GOFS_UNITS = 24;
constexpr int LDS_BYTES = GOFS_OFF + GOFS_UNITS * 1024;
__global__ void __launch_bounds__(512, 2) mega(Params p) {
    cg::grid_group grid = cg::this_grid();
    extern __shared__ __attribute__((aligned(16))) unsigned char smem[];
    float* lds = (float*)smem;
    const int bid = blockIdx.x, nb = gridDim.x;
    unsigned char* ws = p.ws;
    if (threadIdx.x == 0) { *(volatile PG8_LAS unsigned*)((PG8_LAS unsigned char*)smem + 131072) = 0u; *(volatile PG8_LAS unsigned*)((PG8_LAS unsigned char*)smem + 131076) = 0u; }
    __syncthreads();
    const XcdBarrier xbar = xcd_barrier_post((unsigned*)(ws + WS_BAR), (volatile PG8_LAS unsigned*)((PG8_LAS unsigned char*)smem + 131072));
#ifndef PROBE_MASK
#define PROBE_MASK 0
#endif
#define PH(k) for (int rep_ = 0; rep_ < (((PROBE_MASK) >> (k)) & 1 ? 4 : 1); ++rep_)
    PH(0) { const KP q = kargs();  st_prep(q, (PG8_LAS float*)smem, bid, nb);
    st_dft_consts(q, (PG8_LAS float*)smem, bid, nb);
    st_convert_dense(q, (PG8_LAS unsigned*)smem, bid, nb); }
    if (p.ws == nullptr) grid.sync();
    xcd_barrier(xbar);
    PH(1) { const KP q = kargs();  st_hcat(q, (PG8_LAS float*)smem, bid, nb); }
    xcd_barrier(xbar);
    constexpr int CV_NIT = 16 * 3 * 704; const int cvA = nb >= 64 ? CV_NIT - 3 * 8 * (nb - 32) : CV_NIT;
    PH(2) { const KP q = kargs();
      const int NG = nb >= 64 ? (nb * 33 / 64) : nb;
      if (bid < NG) { pg8::Gemm g{(const pg8::bf16_t*)(q->ws + RC_HCAT), (const pg8::bf16_t*)(q->ws + WS_WINT), D_}; SchedDense S; S.init(RT_, DIN_, NG, bid); EpiWin E{q->ws, (const float*)(q->ws + WS_LB)};
        pg8::gemm_phase((PG8_LAS unsigned char*)smem, g, S, E); }
      if (bid >= NG || NG == nb) st_convert_moe(q, (PG8_LAS unsigned*)smem, NG == nb ? bid : bid - NG, NG == nb ? nb : nb - NG, cvA); }
    xcd_barrier(xbar);
    PH(3) { const KP q = kargs();  st_scan1(q, (PG8_LAS unsigned char*)smem, bid, nb);
    st_dft0(q, (PG8_LAS unsigned char*)smem, bid, nb); }
    xcd_barrier(xbar);
    PH(4) { const KP q = kargs();  st_scan2(q, bid, nb);
    st_dftA(q, (PG8_LAS unsigned char*)smem, bid, nb); }
    xcd_barrier(xbar);
    PH(5) { const KP q = kargs();  st_dftC(q, bid, nb);
    st_corr_rec(q, (PG8_LAS unsigned char*)smem, bid, nb); }
    xcd_barrier(xbar);
    PH(7) { const KP q = kargs();  pg8::Gemm g{(const pg8::bf16_t*)(q->ws + RC_MIX), (const pg8::bf16_t*)(q->ws + WS_WOUTT), D_}; SchedDense S; S.init(RL_, D_, nb, bid); EpiWout E{(_Float16*)(q->ws + RC_X1), q->x, (const float*)(q->ws + WS_MOD)};
      pg8::gemm_phase((PG8_LAS unsigned char*)smem, g, S, E); }
    xcd_barrier(xbar);
    PH(8) { const KP q = kargs();  st_router(q, (PG8_LAS float*)smem, bid, nb); }
    xcd_barrier(xbar);
    PH(9) { const KP q = kargs();
      if (nb < 64 || bid < 32) st_topk(q, (PG8_LAS int*)smem, bid, nb);
      else st_convert_tail(q, (PG8_LAS unsigned*)smem, bid - 32, nb - 32, cvA, CV_NIT); }
    xcd_barrier(xbar);
    const bool fuse_gather = (2816 + nb - 1) / nb <= GOFS_UNITS;
    if (!fuse_gather) { PH(10) { const KP q = kargs();  st_gather(q, bid, nb); }
    xcd_barrier(xbar); }
    PH(11) { const KP q = kargs();
      SchedGU S{nb, bid};
      if (fuse_gather) {
        PG8_LAS unsigned* gofs = (PG8_LAS unsigned*)((PG8_LAS unsigned char*)smem + GOFS_OFF);
        { const int* IDX = (const int*)(q->ws + WS_IDX); pg8::Unit u; const int t_ = ltid();
          int iv[GOFS_UNITS / 2]; unsigned ob[GOFS_UNITS / 2];
#pragma unroll
          for (int k2 = 0; k2 < GOFS_UNITS / 2; ++k2) { const int i = 2 * k2 + (t_ >> 8); const bool ok = S.next(i, u); const int row = (ok ? u.pm : 0) * 256 + (t_ & 255), e = row >> 11, bb = (row >> 10) & 1, c = row & 1023;
              iv[k2] = IDX[(bb * 16 + e) * 1024 + c]; ob[k2] = ok ? (unsigned)(bb * L_) : 0xffffffffu; }
#pragma unroll
          for (int k2 = 0; k2 < GOFS_UNITS / 2; ++k2) { const int i = 2 * k2 + (t_ >> 8); if (ob[k2] != 0xffffffffu) gofs[i * 256 + (t_ & 255)] = (ob[k2] + (unsigned)iv[k2]) * (unsigned)D_; }
          __syncthreads(); }
        pg8::Gemm g{(const pg8::bf16_t*)(q->ws + RC_H2B), (const pg8::bf16_t*)(q->ws + WS_WGU), D_ / 2}; EpiGU E{q->ws + RC_HID};
        pg8::gemm_phase<EpiGU, SchedGU, true, 0x79 | (0x7d << 8)>((PG8_LAS unsigned char*)smem, g, S, E, gofs);
      } else {
        pg8::Gemm g{(const pg8::bf16_t*)(q->ws + RC_XS), (const pg8::bf16_t*)(q->ws + WS_WGU), D_ / 2}; EpiGU E{q->ws + RC_HID};
        pg8::gemm_phase<EpiGU, SchedGU, false, 0x79 | (0x7d << 8)>((PG8_LAS unsigned char*)smem, g, S, E);
      } }
    xcd_barrier(xbar);
    PH(12) { const KP q = kargs();  pg8::Gemm g{(const pg8::bf16_t*)(q->ws + RC_HID), (const pg8::bf16_t*)(q->ws + WS_WD), DE_ / 2}; SchedDown S{nb, bid}; EpiDown E{(pg8::bf16_t*)(q->ws + WS_YE), (const float*)(q->ws + WS_GATER)};
      pg8::gemm_phase<EpiDown, SchedDown, false, 0x79 | (0x7c << 8)>((PG8_LAS unsigned char*)smem, g, S, E); }
    xcd_barrier(xbar);
    PH(13) { const KP q = kargs();  st_final(q, bid, nb); }
}

extern "C" void kernel_launch(void* const* d_in, const int* in_sizes, int n_in, void* d_out, int out_size, void* d_ws, size_t ws_size, hipStream_t stream) {
    static int grid_blocks = 0;
    if (!grid_blocks) {
        int dev = 0, cus = 0, per_cu = 0;
        (void)hipGetDevice(&dev);
        (void)hipDeviceGetAttribute(&cus, hipDeviceAttributeMultiprocessorCount, dev);
        if (hipFuncSetAttribute((const void*)mega, hipFuncAttributeMaxDynamicSharedMemorySize, LDS_BYTES) != hipSuccess) fprintf(stderr, "hipFuncSetAttribute failed\n");
        (void)hipOccupancyMaxActiveBlocksPerMultiprocessor(&per_cu, mega, 512, LDS_BYTES);
        if (per_cu < 1) per_cu = 1;
        grid_blocks = cus * per_cu;
        if (ws_size < WS_END) { fprintf(stderr, "workspace too small: %zu < %zu\n", ws_size, (size_t)WS_END); grid_blocks = -1; }
    }
    if (grid_blocks < 0) return;
    Params p{};
    const float** pp = (const float**)&p;
    for (int i = 0; i < 18; ++i) pp[i] = (const float*)d_in[i];
    p.out = (float*)d_out; p.ws = (unsigned char*)d_ws;
    (void)hipMemsetAsync((unsigned char*)d_ws + WS_BAR, 0, XCD_BAR_WORDS * 4, stream);
    void* args[] = {&p};
    hipError_t e = hipLaunchCooperativeKernel((void*)mega, dim3(grid_blocks), dim3(512), args, LDS_BYTES, stream);
    if (e != hipSuccess) fprintf(stderr, "cooperative launch failed: %s (grid %d)\n", hipGetErrorString(e), grid_blocks);
}
```
